# Optimizing an MI355X kernel written in HIP

```python
import math
import jax
import jax.numpy as jnp
from jax import lax
import numpy as np

D_MODEL = 1024
BATCH = 16
SEQ = 256
DEPTH = 4
DEC_BATCH = 2
DEC_SEQ = 2048
PAST_LEN = 256

GRID_W = 64
N_MIXERS = 2
N_ATTN_LAYERS = (DEPTH + 1) // 2
N_SSM_LAYERS = DEPTH // 2
N_MOD = 9
D_FF = 2816
MLA_HEADS = 16
Q_LORA = 512
KV_LORA = 256
QK_NOPE = 64
QK_ROPE = 32
V_HEAD = 64
QK_HEAD = QK_NOPE + QK_ROPE
MLA_IN = Q_LORA + KV_LORA + QK_ROPE
CACHE_DIM = KV_LORA + QK_ROPE
ROPE_BASE = 10000.0
Q_BLOCK = 128
SSM_EXPAND = 2
D_INNER = SSM_EXPAND * D_MODEL
SSM_HEADDIM = 64
SSM_HEADS = D_INNER // SSM_HEADDIM
SSM_GROUPS = 4
D_STATE = 128
CONV_W = 5
CONV_DIM = D_INNER + 2 * SSM_GROUPS * D_STATE
SSM_IN = D_INNER + CONV_DIM + 2 * SSM_HEADS
CHUNK = 128
EPS = 1e-6

kernel_name = 'hybrid_mla_ssd_prefix_diffusion_step'


def rmsnorm(x, g):
    x32 = x.astype(jnp.float32)
    y = x32 * lax.rsqrt(jnp.mean(x32 * x32, axis=-1, keepdims=True) + EPS)
    return (y * g.astype(jnp.float32)).astype(x.dtype)


def adaln_input(x, g, shift, scale):
    return rmsnorm(x, g) * (1 + scale) + shift


def modulation(sc, w, b):
    m = (sc @ w + b).reshape(sc.shape[0], N_MOD, D_MODEL)
    return [m[:, k, None, :] for k in range(N_MOD)]


def swiglu(h, w_in, w_out):
    gate, up = jnp.split(h @ w_in, 2, axis=-1)
    return (jax.nn.silu(gate) * up) @ w_out


def ffn_half(x, shift, scale, gate, g, w_in, w_out):
    return x + 0.5 * gate * swiglu(adaln_input(x, g, shift, scale), w_in, w_out)


def axial_rope_tables(seq_len):
    rows = seq_len // GRID_W
    row = jnp.repeat(jnp.arange(rows), GRID_W)
    col = jnp.tile(jnp.arange(GRID_W), rows)
    pos = jnp.stack([row, col], axis=-1).astype(jnp.float32)
    half = QK_ROPE // 2
    freqs = 1.0 / (ROPE_BASE ** (jnp.arange(0, half, 2, dtype=jnp.float32) / half))
    ang = pos[:, :, None] * freqs
    ang = jnp.broadcast_to(ang[:, :, None, :], (seq_len, 2, 2, half // 2))
    return jnp.cos(ang), jnp.sin(ang)


def apply_axial_rope(x, cos, sin):
    xr = x.astype(jnp.float32).reshape(x.shape[:-1] + (2, 2, QK_ROPE // 4))
    rot = jnp.stack([-xr[..., 1, :], xr[..., 0, :]], axis=-2)
    return (xr * cos + rot * sin).reshape(x.shape).astype(x.dtype)


def block_attention(q, k, v):
    b, lq, h, dk = q.shape
    nb = lq // Q_BLOCK
    qb = q.reshape(b, nb, Q_BLOCK, h, dk).transpose(1, 0, 2, 3, 4)
    k32 = k.astype(jnp.float32)
    v32 = v.astype(jnp.float32)
    scale = 1.0 / math.sqrt(dk)

    def one_block(qblk):
        s = jnp.einsum('bqhd,bkhd->bhqk', qblk.astype(jnp.float32), k32) * scale
        p = jax.nn.softmax(s, axis=-1)
        return jnp.einsum('bhqk,bkhd->bqhd', p, v32)

    o = lax.map(one_block, qb)
    return o.transpose(1, 0, 2, 3, 4).reshape(b, lq, h, -1).astype(q.dtype)


def mla_project(h, w_in, q_norm, kv_norm, wq_b):
    b, l, _ = h.shape
    q_a, kv_a, k_r = jnp.split(h @ w_in, [Q_LORA, Q_LORA + KV_LORA], axis=-1)
    q = (rmsnorm(q_a, q_norm) @ wq_b).reshape(b, l, MLA_HEADS, QK_HEAD)
    ckv = rmsnorm(kv_a, kv_norm)
    return q, ckv, k_r


def mla_expand_kv(ckv, k_r, wkv_b):
    b, l, _ = ckv.shape
    kv = (ckv @ wkv_b).reshape(b, l, MLA_HEADS, QK_NOPE + V_HEAD)
    k_nope, v = jnp.split(kv, [QK_NOPE], axis=-1)
    k = jnp.concatenate([k_nope, jnp.broadcast_to(k_r[:, :, None, :], (b, l, MLA_HEADS, QK_ROPE))], axis=-1)
    return k, v


def mla_context(h, w_in, q_norm, kv_norm, wq_b, wkv_b, wo):
    b, l, _ = h.shape
    q, ckv, k_r = mla_project(h, w_in, q_norm, kv_norm, wq_b)
    k, v = mla_expand_kv(ckv, k_r, wkv_b)
    o = block_attention(q, k, v)
    out = o.reshape(b, l, MLA_HEADS * V_HEAD) @ wo
    return out, jnp.concatenate([ckv, k_r], axis=-1)


def mla_latent(h, cache, cos, sin, w_in, q_norm, kv_norm, wq_b, wkv_b, wo):
    b, l, _ = h.shape
    q, ckv, k_r = mla_project(h, w_in, q_norm, kv_norm, wq_b)
    q = jnp.concatenate([q[..., :QK_NOPE], apply_axial_rope(q[..., QK_NOPE:], cos[:, None], sin[:, None])], axis=-1)
    k_r = apply_axial_rope(k_r, cos, sin)
    k_lat, v_lat = mla_expand_kv(ckv, k_r, wkv_b)
    k_ctx, v_ctx = mla_expand_kv(cache[..., :KV_LORA], cache[..., KV_LORA:], wkv_b)
    k = jnp.concatenate([k_ctx, k_lat], axis=1)
    v = jnp.concatenate([v_ctx, v_lat], axis=1)
    o = block_attention(q, k, v)
    return o.reshape(b, l, MLA_HEADS * V_HEAD) @ wo


def centred_depthwise_conv(x, w, bias):
    out = lax.conv_general_dilated(
        x, w[:, None, :], window_strides=(1,), padding=[(CONV_W // 2, CONV_W // 2)],
        dimension_numbers=('NWC', 'WIO', 'NWC'), feature_group_count=x.shape[-1])
    return out + bias


def ssd_chunked(x, dt, a, bmat, cmat, h0):
    b, l, h, p = x.shape
    g = SSM_GROUPS
    r = h // g
    nc = l // CHUNK
    xg = x.reshape(b, nc, CHUNK, g, r, p)
    dtg = dt.reshape(b, nc, CHUNK, g, r)
    bg = bmat.reshape(b, nc, CHUNK, g, D_STATE)
    cg = cmat.reshape(b, nc, CHUNK, g, D_STATE)
    cum = jnp.cumsum(dtg * a.reshape(g, r), axis=2)
    xdt = xg * dtg[..., None]
    seg = cum[:, :, :, None] - cum[:, :, None, :]
    mask = jnp.tril(jnp.ones((CHUNK, CHUNK), dtype=bool))[:, :, None, None]
    lmat = jnp.exp(jnp.where(mask, seg, -jnp.inf))
    cb = jnp.einsum('bcign,bcjgn->bcijg', cg, bg)
    y_diag = jnp.einsum('bcijg,bcijgr,bcjgrp->bcigrp', cb, lmat, xdt)
    decay_end = jnp.exp(cum[:, :, -1:] - cum)
    states = jnp.einsum('bcjgn,bcjgr,bcjgrp->bcgrpn', bg, decay_end, xdt)
    chunk_decay = jnp.exp(cum[:, :, -1])

    def step(hc, inp):
        st, dc = inp
        return hc * dc[..., None, None] + st, hc

    h_fin, h_in = lax.scan(step, h0.reshape(b, g, r, p, D_STATE),
                           (states.transpose(1, 0, 2, 3, 4, 5), chunk_decay.transpose(1, 0, 2, 3)))
    h_in = h_in.transpose(1, 0, 2, 3, 4, 5)
    y_off = jnp.einsum('bcign,bcigr,bcgrpn->bcigrp', cg, jnp.exp(cum), h_in)
    y = (y_diag + y_off).reshape(b, l, h, p)
    return y, h_fin.reshape(b, h, p, D_STATE)


def ssm_mixer(h, h0, w_in, conv_w, conv_b, dt_bias, a_log, d_skip, norm_g, w_out):
    b, l, _ = h.shape
    z, xbc, dt_raw = jnp.split(h @ w_in, [D_INNER, D_INNER + CONV_DIM], axis=-1)
    xbc = jax.nn.silu(centred_depthwise_conv(xbc, conv_w, conv_b))
    xs, bm, cm = jnp.split(xbc, [D_INNER, D_INNER + SSM_GROUPS * D_STATE], axis=-1)
    xs = xs.reshape(b, l, SSM_HEADS, SSM_HEADDIM).astype(jnp.float32)
    bm = bm.reshape(b, l, SSM_GROUPS, D_STATE).astype(jnp.float32)
    cm = cm.reshape(b, l, SSM_GROUPS, D_STATE).astype(jnp.float32)
    dt = jax.nn.softplus(dt_raw.reshape(b, l, 2, SSM_HEADS).astype(jnp.float32) + dt_bias.astype(jnp.float32))
    a = -jnp.exp(a_log.astype(jnp.float32))
    h0f = h0.astype(jnp.float32)
    y_f, h_f = ssd_chunked(xs, dt[:, :, 0], a[0], bm, cm, h0f[:, 0])
    y_b, h_b = ssd_chunked(xs[:, ::-1], dt[:, ::-1, 1], a[1], bm[:, ::-1], cm[:, ::-1], h0f[:, 1])
    dsum = (d_skip[0] + d_skip[1]).astype(jnp.float32)
    y = y_f + y_b[:, ::-1] + dsum[:, None] * xs
    y = y.reshape(b, l, D_INNER).astype(h.dtype)
    y = rmsnorm(y * jax.nn.silu(z), norm_g)
    return y @ w_out, jnp.stack([h_f, h_b], axis=1).astype(h.dtype)


def setup_inputs(seed: int = 0) -> dict:
    key = jax.random.key(seed)
    ks = jax.random.split(key, 32)

    def nrm(k, shape, scale):
        return scale * jax.random.normal(k, shape, jnp.float32)

    na, ns = N_ATTN_LAYERS, N_SSM_LAYERS
    dt0 = jnp.exp(jax.random.uniform(ks[20], (ns, 2, SSM_HEADS), jnp.float32, math.log(1e-3), math.log(1e-1)))
    dt_bias = dt0 + jnp.log(-jnp.expm1(-dt0))
    a_log = jnp.log(jax.random.uniform(ks[21], (ns, 2, SSM_HEADS), jnp.float32, 1.0, 16.0))
    return {
        'x_prompt': nrm(ks[0], (BATCH, SEQ, D_MODEL), 1.0),
        'x_sample': nrm(ks[1], (DEC_BATCH, DEC_SEQ, D_MODEL), 1.0),
        'cache_mla': nrm(ks[2], (DEC_BATCH, na, PAST_LEN, CACHE_DIM), 1.0),
        'state_ssm': nrm(ks[3], (DEC_BATCH, ns, 2, SSM_HEADS, SSM_HEADDIM, D_STATE), 0.5),
        'c': nrm(ks[4], (DEC_BATCH, D_MODEL), 1.0),
        'c_ctx': nrm(ks[5], (D_MODEL,), 1.0),
        'mod_w': nrm(ks[6], (DEPTH, D_MODEL, N_MOD * D_MODEL), 0.5 * D_MODEL ** -0.5),
        'mod_b': nrm(ks[7], (DEPTH, N_MOD * D_MODEL), 0.02),
        'norm_g': 1.0 + nrm(ks[8], (DEPTH, 3, D_MODEL), 0.05),
        'ffn_w_in': nrm(ks[9], (DEPTH, 2, D_MODEL, 2 * D_FF), D_MODEL ** -0.5),
        'ffn_w_out': nrm(ks[10], (DEPTH, 2, D_FF, D_MODEL), D_FF ** -0.5),
        'mla_w_in': nrm(ks[11], (na, D_MODEL, MLA_IN), D_MODEL ** -0.5),
        'mla_q_norm': 1.0 + nrm(ks[12], (na, Q_LORA), 0.05),
        'mla_kv_norm': 1.0 + nrm(ks[13], (na, KV_LORA), 0.05),
        'mla_wq_b': nrm(ks[14], (na, Q_LORA, MLA_HEADS * QK_HEAD), Q_LORA ** -0.5),
        'mla_wkv_b': nrm(ks[15], (na, KV_LORA, MLA_HEADS * (QK_NOPE + V_HEAD)), KV_LORA ** -0.5),
        'mla_wo': nrm(ks[16], (na, MLA_HEADS * V_HEAD, D_MODEL), (MLA_HEADS * V_HEAD) ** -0.5),
        'ssm_w_in': nrm(ks[17], (ns, D_MODEL, SSM_IN), D_MODEL ** -0.5),
        'ssm_conv_w': nrm(ks[18], (ns, CONV_W, CONV_DIM), CONV_W ** -0.5),
        'ssm_conv_b': nrm(ks[19], (ns, CONV_DIM), 0.02),
        'ssm_dt_bias': dt_bias,
        'ssm_a_log': a_log,
        'ssm_d': 1.0 + nrm(ks[22], (ns, 2, SSM_HEADS), 0.1),
        'ssm_norm_g': 1.0 + nrm(ks[23], (ns, D_INNER), 0.05),
        'ssm_w_out': nrm(ks[24], (ns, D_INNER, D_MODEL), D_INNER ** -0.5),
        'final_norm_g': 1.0 + nrm(ks[25], (D_MODEL,), 0.05),
    }


def reference(x_prompt, x_sample, cache_mla, state_ssm, c, c_ctx, mod_w, mod_b, norm_g,
              ffn_w_in, ffn_w_out, mla_w_in, mla_q_norm, mla_kv_norm, mla_wq_b, mla_wkv_b, mla_wo,
              ssm_w_in, ssm_conv_w, ssm_conv_b, ssm_dt_bias, ssm_a_log, ssm_d, ssm_norm_g, ssm_w_out,
              final_norm_g):
    cos, sin = axial_rope_tables(x_sample.shape[1])
    xp, xs = x_prompt, x_sample
    sc_ctx = jax.nn.silu(c_ctx)[None, :]
    sc_lat = jax.nn.silu(c)
    new_mla, new_ssm = [], []
    for i in range(DEPTH):
        m_ctx = modulation(sc_ctx, mod_w[i], mod_b[i])
        m_lat = modulation(sc_lat, mod_w[i], mod_b[i])
        xp = ffn_half(xp, m_ctx[0], m_ctx[1], m_ctx[2], norm_g[i, 0], ffn_w_in[i, 0], ffn_w_out[i, 0])
        xs = ffn_half(xs, m_lat[0], m_lat[1], m_lat[2], norm_g[i, 0], ffn_w_in[i, 0], ffn_w_out[i, 0])
        hp = adaln_input(xp, norm_g[i, 1], m_ctx[3], m_ctx[4])
        hs = adaln_input(xs, norm_g[i, 1], m_lat[3], m_lat[4])
        j = i // N_MIXERS
        if i % N_MIXERS == 0:
            wts = (mla_w_in[j], mla_q_norm[j], mla_kv_norm[j], mla_wq_b[j], mla_wkv_b[j], mla_wo[j])
            op, ctx_entry = mla_context(hp, *wts)
            os_ = mla_latent(hs, cache_mla[:, j], cos, sin, *wts)
            new_mla.append(ctx_entry)
        else:
            wts = (ssm_w_in[j], ssm_conv_w[j], ssm_conv_b[j], ssm_dt_bias[j], ssm_a_log[j], ssm_d[j],
                   ssm_norm_g[j], ssm_w_out[j])
            zero_state = jnp.zeros((xp.shape[0], 2, SSM_HEADS, SSM_HEADDIM, D_STATE), xp.dtype)
            op, ctx_state = ssm_mixer(hp, zero_state, *wts)
            os_, _ = ssm_mixer(hs, state_ssm[:, j], *wts)
            new_ssm.append(ctx_state)
        xp = xp + m_ctx[5] * op
        xs = xs + m_lat[5] * os_
        xp = ffn_half(xp, m_ctx[6], m_ctx[7], m_ctx[8], norm_g[i, 2], ffn_w_in[i, 1], ffn_w_out[i, 1])
        xs = ffn_half(xs, m_lat[6], m_lat[7], m_lat[8], norm_g[i, 2], ffn_w_in[i, 1], ffn_w_out[i, 1])
    y_prompt = rmsnorm(xp, final_norm_g)
    y_sample = rmsnorm(xs, final_norm_g)
    new_cache_mla = jnp.stack(new_mla, axis=1)
    new_state_ssm = jnp.stack(new_ssm, axis=1)
    return (y_prompt, y_sample, new_cache_mla, new_state_ssm)
```

```cpp
#include <hip/hip_runtime.h>
#include <hip/hip_cooperative_groups.h>
#include <cstdio>
#include <cstring>
namespace cg = cooperative_groups;

#ifndef N_LAUNCH_MODE
#define N_LAUNCH_MODE 1
#endif

typedef unsigned short bf16_t;
typedef short bf16x8 __attribute__((ext_vector_type(8)));
typedef float f32x4 __attribute__((ext_vector_type(4)));
typedef unsigned u32x2 __attribute__((ext_vector_type(2)));
typedef unsigned u32x4 __attribute__((ext_vector_type(4)));

constexpr int NT = 512;
constexpr int NTOK = 8192;
constexpr int NTOKKV = 8704;
constexpr int D = 1024, DFF = 2816, NMODC = 9216;
constexpr int SSM_NPAD = 5376;
constexpr int MLA_NPAD = 896;
constexpr float EPS = 1e-6f;

constexpr size_t al256(size_t x) { return (x + 255) & ~(size_t)255; }
constexpr size_t WS_X = 0;
constexpr size_t WS_H = WS_X + al256((size_t)NTOK * D * 4);
constexpr size_t WS_U = WS_H + al256((size_t)NTOK * D * 2);
constexpr size_t WS_MOD = WS_U + al256((size_t)NTOK * DFF * 2);
constexpr size_t WS_ROPE = WS_MOD + al256((size_t)4 * 3 * NMODC * 4);
constexpr size_t WS_W1T = WS_ROPE + al256((size_t)2048 * 32 * 4);
constexpr size_t WS_W2T = WS_W1T + al256((size_t)8 * 5632 * 1024 * 2);
constexpr size_t WS_MWIN = WS_W2T + al256((size_t)8 * 1024 * 2816 * 2);
constexpr size_t WS_MWQB = WS_MWIN + al256((size_t)2 * MLA_NPAD * 1024 * 2);
constexpr size_t WS_MWKN = WS_MWQB + al256((size_t)2 * 1536 * 512 * 2);
constexpr size_t WS_MWV = WS_MWKN + al256((size_t)2 * 1024 * 256 * 2);
constexpr size_t WS_MWO = WS_MWV + al256((size_t)2 * 1024 * 256 * 2);
constexpr size_t WS_SWIN = WS_MWO + al256((size_t)2 * 1024 * 1024 * 2);
constexpr size_t WS_SWOUT = WS_SWIN + al256((size_t)2 * SSM_NPAD * 1024 * 2);
constexpr size_t WS_TMP = WS_SWOUT + al256((size_t)2 * 1024 * 2048 * 2);
constexpr size_t WS_QKVA = WS_TMP;
constexpr size_t WS_QA = WS_QKVA + al256((size_t)NTOK * 800 * 4);
constexpr size_t WS_CKV = WS_QA + al256((size_t)NTOK * 512 * 2);
constexpr size_t WS_KR = WS_CKV + al256((size_t)NTOKKV * 256 * 2);
constexpr size_t WS_Q = WS_KR + al256((size_t)NTOKKV * 32 * 2);
constexpr size_t WS_KN = WS_Q + al256((size_t)NTOK * 1536 * 2);
constexpr size_t WS_VT = WS_KN + al256((size_t)NTOKKV * 1024 * 2);
constexpr size_t WS_O = WS_VT + al256((size_t)1024 * NTOKKV * 2);
constexpr size_t WS_MLA_END = WS_O + al256((size_t)NTOK * 1024 * 2);
constexpr size_t WS_ZXB = WS_TMP;
constexpr size_t WS_DTRAW = WS_ZXB + al256((size_t)NTOK * 5120 * 2);
constexpr size_t WS_XS = WS_DTRAW + al256((size_t)NTOK * 64 * 4);
constexpr size_t WS_XT = WS_XS + al256((size_t)NTOK * 2048 * 2);
constexpr size_t WS_BM = WS_XT + al256((size_t)NTOK * 2048 * 2);
constexpr size_t WS_BT = WS_BM + al256((size_t)NTOK * 512 * 2);
constexpr size_t WS_CM = WS_BT + al256((size_t)NTOK * 512 * 2);
constexpr size_t WS_DT = WS_CM + al256((size_t)NTOK * 512 * 2);
constexpr size_t WS_YF = WS_DT + al256((size_t)NTOK * 64 * 4);
constexpr size_t WS_YB = WS_YF + al256((size_t)NTOK * 2048 * 2);
constexpr size_t WS_YN = WS_YB + al256((size_t)NTOK * 2048 * 2);
constexpr size_t WS_SSM_END = WS_YN + al256((size_t)NTOK * 2048 * 2);
constexpr size_t WS_BAR = WS_SSM_END > WS_MLA_END ? WS_SSM_END : WS_MLA_END;
constexpr size_t WS_END = WS_BAR + 16384;

constexpr size_t OUT_Y = 0;
constexpr size_t OUT_CACHE = (size_t)NTOK * D;
constexpr size_t OUT_STATE = OUT_CACHE + (size_t)16 * 2 * 256 * 288;

constexpr int LDS_BYTES = 141312;

struct Params {
    const float* in[26];
    float* out;
    unsigned char* ws;
    int ph_lo, ph_hi;
};

typedef __bf16 bf16v2_t __attribute__((ext_vector_type(2)));
typedef float f32v2_t __attribute__((ext_vector_type(2)));
__device__ __forceinline__ unsigned pk2(float lo, float hi) { f32v2_t f = {lo, hi}; bf16v2_t b = __builtin_convertvector(f, bf16v2_t); return __builtin_bit_cast(unsigned, b); }
__device__ __forceinline__ bf16_t f2bf(float f) { return (bf16_t)(pk2(f, 0.f) & 0xffffu); }
__device__ __forceinline__ float bflo(unsigned u) { return __uint_as_float(u << 16); }
__device__ __forceinline__ float bfhi(unsigned u) { return __uint_as_float(u & 0xffff0000u); }
__device__ __forceinline__ float silu_f(float x) { return x / (1.f + __expf(-x)); }
__device__ __forceinline__ float wave_sum(float v) {
#pragma unroll
    for (int o = 32; o > 0; o >>= 1) v += __shfl_xor(v, o);
    return v;
}
__device__ __forceinline__ u32x2 pack4(f32x4 v) { u32x2 r; r.x = pk2(v[0], v[1]); r.y = pk2(v[2], v[3]); return r; }
__device__ __forceinline__ f32x4 mfma16(bf16x8 a, bf16x8 b, f32x4 c) { return __builtin_amdgcn_mfma_f32_16x16x32_bf16(a, b, c, 0, 0, 0); }
__device__ __forceinline__ int modrow(int tok) { return tok < 4096 ? 0 : 1 + ((tok - 4096) >> 11); }

__device__ __forceinline__ int tid_opaque() { int t = threadIdx.x; asm volatile("" : "+v"(t)); return t; }
__device__ __forceinline__ int bid_opaque() { int t = blockIdx.x; asm volatile("" : "+s"(t)); return t; }
__device__ __forceinline__ void conv_tile(const float* __restrict__ src, int ldsrc, int nvalid, int mode, bf16_t* __restrict__ dst, int K, int n0, int k0, bf16_t* tile) {
    const int tid = tid_opaque();
    {
        const int nn = tid & 63, kr = tid >> 6, n = n0 + nn;
        int col; bool valid = true;
        if (mode == 0) { col = n; valid = n < nvalid; }
        else if (mode == 1) { const int q = n >> 8, w = n & 255; col = (w < 128) ? (q * 128 + w) : (DFF + q * 128 + (w - 128)); }
        else if (mode == 2) { col = (n >> 6) * 128 + (n & 63); }
        else { col = (n >> 6) * 128 + 64 + (n & 63); }
        const float* s = src + (size_t)(k0 + kr) * ldsrc + col;
#pragma unroll
        for (int ps = 0; ps < 8; ++ps) {
            const float v = valid ? __builtin_nontemporal_load(s + (size_t)(ps * 8) * ldsrc) : 0.f;
            tile[nn * 66 + ps * 8 + kr] = f2bf(v);
        }
    }
    __syncthreads();
    {
        const int nn = tid >> 3, ch = tid & 7;
        const unsigned* t32 = (const unsigned*)tile + nn * 33 + ch * 4;
        u32x4 o; o.x = t32[0]; o.y = t32[1]; o.z = t32[2]; o.w = t32[3];
        *(u32x4*)(dst + (size_t)(n0 + nn) * K + k0 + ch * 8) = o;
    }
    __syncthreads();
}

__device__ __forceinline__ void phase0(const Params& p, unsigned char* smem) {
    const int tid = tid_opaque(), G = gridDim.x, b = bid_opaque();
    float* X = (float*)(p.ws + WS_X);
    {
        const f32x4* xp = (const f32x4*)p.in[0]; const f32x4* xs = (const f32x4*)p.in[1]; f32x4* xo = (f32x4*)X;
        const int n4 = NTOK * D / 4, half = n4 / 2;
        for (int i = b * NT + tid; i < n4; i += G * NT) xo[i] = i < half ? xp[i] : xs[i - half];
    }
    {
        float* rope = (float*)(p.ws + WS_ROPE);
        for (int i = b * NT + tid; i < 2048 * 16; i += G * NT) {
            const int pos = i >> 4, a = (i >> 3) & 1, f = i & 7;
            const double position = a == 0 ? (double)(pos >> 6) : (double)(pos & 63);
            double freq = (f & 1) ? 0.31622776601683794 : 1.0;
            const int f2 = f >> 1; if (f2 == 1) freq *= 0.1; else if (f2 == 2) freq *= 0.01; else if (f2 == 3) freq *= 0.001;
            const double ang = position * freq;
            const double kq = rint(ang * 0.63661977236758134);
            const double r = ang - kq * 1.5707963267948966;
            const double r2 = r * r;
            double sn = r * (1.0 + r2 * (-1.0 / 6 + r2 * (1.0 / 120 + r2 * (-1.0 / 5040 + r2 * (1.0 / 362880 + r2 * (-1.0 / 39916800 + r2 * (1.0 / 6227020800.0 + r2 * (-1.0 / 1307674368000.0))))))));
            double cs = 1.0 + r2 * (-0.5 + r2 * (1.0 / 24 + r2 * (-1.0 / 720 + r2 * (1.0 / 40320 + r2 * (-1.0 / 3628800 + r2 * (1.0 / 479001600.0 + r2 * (-1.0 / 87178291200.0 + r2 * (1.0 / 20922789888000.0))))))));
            const int q = ((int)kq) & 3;
            double c, s;
            if (q == 0) { c = cs; s = sn; } else if (q == 1) { c = -sn; s = cs; } else if (q == 2) { c = -cs; s = -sn; } else { c = sn; s = -cs; }
            rope[pos * 32 + a * 8 + f] = (float)c;
            rope[pos * 32 + 16 + a * 8 + f] = (float)s;
        }
    }
    {
        float* sc = (float*)smem; float* red = sc + 3072;
        const float* cin = p.in[4]; const float* cctx = p.in[5];
        for (int i = tid; i < 3072; i += NT) { const int row = i >> 10, k = i & 1023; const float c = row == 0 ? cctx[k] : cin[(row - 1) * 1024 + k]; sc[i] = silu_f(c); }
        __syncthreads();
        float* MOD = (float*)(p.ws + WS_MOD);
        for (int item = b; item < 4 * 288; item += G) {
            const int layer = item / 288, col0 = (item % 288) * 32;
            const int cq = tid & 7, ks = tid >> 3;
            const float* w = p.in[6] + (size_t)layer * 1024 * NMODC + (size_t)(ks * 16) * NMODC + col0 + cq * 4;
            f32x4 a0 = {0.f, 0.f, 0.f, 0.f}, a1 = a0, a2 = a0;
            f32x4 wv[16];
#pragma unroll
            for (int kk = 0; kk < 16; ++kk) wv[kk] = __builtin_nontemporal_load((const f32x4*)(w + (size_t)kk * NMODC));
            asm volatile("" ::: "memory");
#pragma unroll
            for (int kk = 0; kk < 16; ++kk) {
                const int k = ks * 16 + kk;
                a0 += sc[k] * wv[kk]; a1 += sc[1024 + k] * wv[kk]; a2 += sc[2048 + k] * wv[kk];
            }
            *(f32x4*)(red + ks * 96 + cq * 4) = a0; *(f32x4*)(red + ks * 96 + 32 + cq * 4) = a1; *(f32x4*)(red + ks * 96 + 64 + cq * 4) = a2;
            __syncthreads();
            if (tid < 96) {
                float s = 0.f;
                for (int k2 = 0; k2 < 64; ++k2) s += red[k2 * 96 + tid];
                const int row = tid >> 5, c = tid & 31;
                MOD[(size_t)(layer * 3 + row) * NMODC + col0 + c] = s + p.in[7][(size_t)layer * NMODC + col0 + c];
            }
            __syncthreads();
        }
    }
    {
        bf16_t* tile = (bf16_t*)smem;
        constexpr int T_W1 = 88 * 16, T_W2 = 16 * 44, T_MIN = 14 * 16, T_MQB = 24 * 8, T_MKV = 16 * 4, T_MO = 16 * 16, T_SIN = 84 * 16, T_SOUT = 16 * 32;
        constexpr int TOTAL = 8 * T_W1 + 8 * T_W2 + 2 * (T_MIN + T_MQB + 2 * T_MKV + T_MO) + 2 * (T_SIN + T_SOUT);
        const int nn = tid & 63, kr = tid >> 6, on = tid >> 3, och = tid & 7;
        for (int t0 = b; t0 < TOTAL; t0 += 4 * G) {
            float v[4][8];
            bf16_t* dsts[4];
#pragma unroll
            for (int u = 0; u < 4; ++u) {
                int r = t0 + u * G;
                const bool live = r < TOTAL;
                if (!live) r = 0;
                const float* src; bf16_t* dst; int K, ld, nvalid, mode;
                if (r < 8 * T_W1) { const int j = r / T_W1; r -= j * T_W1; src = p.in[9] + (size_t)j * 1024 * 5632; dst = (bf16_t*)(p.ws + WS_W1T) + (size_t)j * 5632 * 1024; K = 1024; ld = 5632; nvalid = 5632; mode = 1; }
                else if ((r -= 8 * T_W1) < 8 * T_W2) { const int j = r / T_W2; r -= j * T_W2; src = p.in[10] + (size_t)j * 2816 * 1024; dst = (bf16_t*)(p.ws + WS_W2T) + (size_t)j * 1024 * 2816; K = 2816; ld = 1024; nvalid = 1024; mode = 0; }
                else if ((r -= 8 * T_W2) < 2 * T_MIN) { const int j = r / T_MIN; r -= j * T_MIN; src = p.in[11] + (size_t)j * 1024 * 800; dst = (bf16_t*)(p.ws + WS_MWIN) + (size_t)j * MLA_NPAD * 1024; K = 1024; ld = 800; nvalid = 800; mode = 0; }
                else if ((r -= 2 * T_MIN) < 2 * T_MQB) { const int j = r / T_MQB; r -= j * T_MQB; src = p.in[14] + (size_t)j * 512 * 1536; dst = (bf16_t*)(p.ws + WS_MWQB) + (size_t)j * 1536 * 512; K = 512; ld = 1536; nvalid = 1536; mode = 0; }
                else if ((r -= 2 * T_MQB) < 2 * T_MKV) { const int j = r / T_MKV; r -= j * T_MKV; src = p.in[15] + (size_t)j * 256 * 2048; dst = (bf16_t*)(p.ws + WS_MWKN) + (size_t)j * 1024 * 256; K = 256; ld = 2048; nvalid = 1024; mode = 2; }
                else if ((r -= 2 * T_MKV) < 2 * T_MKV) { const int j = r / T_MKV; r -= j * T_MKV; src = p.in[15] + (size_t)j * 256 * 2048; dst = (bf16_t*)(p.ws + WS_MWV) + (size_t)j * 1024 * 256; K = 256; ld = 2048; nvalid = 1024; mode = 3; }
                else if ((r -= 2 * T_MKV) < 2 * T_MO) { const int j = r / T_MO; r -= j * T_MO; src = p.in[16] + (size_t)j * 1024 * 1024; dst = (bf16_t*)(p.ws + WS_MWO) + (size_t)j * 1024 * 1024; K = 1024; ld = 1024; nvalid = 1024; mode = 0; }
                else if ((r -= 2 * T_MO) < 2 * T_SIN) { const int j = r / T_SIN; r -= j * T_SIN; src = p.in[17] + (size_t)j * 1024 * 5184; dst = (bf16_t*)(p.ws + WS_SWIN) + (size_t)j * SSM_NPAD * 1024; K = 1024; ld = 5184; nvalid = 5184; mode = 0; }
                else { r -= 2 * T_SIN; const int j = r / T_SOUT; r -= j * T_SOUT; src = p.in[24] + (size_t)j * 2048 * 1024; dst = (bf16_t*)(p.ws + WS_SWOUT) + (size_t)j * 1024 * 2048; K = 2048; ld = 1024; nvalid = 1024; mode = 0; }
                const int nkt = K >> 6, n0 = (r / nkt) * 64, k0 = (r % nkt) * 64, n = n0 + nn;
                int col; bool valid = live;
                if (mode == 0) { col = n; valid = valid && n < nvalid; }
                else if (mode == 1) { const int q = n >> 8, w = n & 255; col = (w < 128) ? (q * 128 + w) : (DFF + q * 128 + (w - 128)); }
                else if (mode == 2) { col = (n >> 6) * 128 + (n & 63); }
                else { col = (n >> 6) * 128 + 64 + (n & 63); }
                const float* sp = src + (size_t)(k0 + kr) * ld + (valid ? col : 0);
#pragma unroll
                for (int ps = 0; ps < 8; ++ps) { const float x = __builtin_nontemporal_load(sp + (size_t)(ps * 8) * ld); v[u][ps] = valid ? x : 0.f; }
                dsts[u] = live ? dst + (size_t)(n0 + on) * K + k0 + och * 8 : nullptr;
            }
#pragma unroll
            for (int u = 0; u < 4; ++u)
#pragma unroll
                for (int ps = 0; ps < 8; ++ps) tile[u * 4224 + nn * 66 + ps * 8 + kr] = f2bf(v[u][ps]);
            __syncthreads();
#pragma unroll
            for (int u = 0; u < 4; ++u) {
                const unsigned* t32 = (const unsigned*)(tile + u * 4224) + on * 33 + och * 4;
                u32x4 o; o.x = t32[0]; o.y = t32[1]; o.z = t32[2]; o.w = t32[3];
                if (dsts[u]) *(u32x4*)dsts[u] = o;
            }
            __syncthreads();
        }
    }
}

__device__ __forceinline__ void phase_norm(const float* __restrict__ X, const float* __restrict__ g, const float* __restrict__ modl, int shift_chunk, int scale_chunk, bf16_t* __restrict__ H) {
    const int tid_ = tid_opaque(); const int lane = tid_ & 63, gw = bid_opaque() * 8 + (tid_ >> 6), nW = gridDim.x * 8;
#pragma unroll 4
    for (int tok = gw; tok < NTOK; tok += nW) {
        const float* xr = X + (size_t)tok * D + lane * 4;
        f32x4 v[4]; float ss = 0.f;
#pragma unroll
        for (int j = 0; j < 4; ++j) { v[j] = *(const f32x4*)(xr + 256 * j); ss += v[j][0] * v[j][0] + v[j][1] * v[j][1] + v[j][2] * v[j][2] + v[j][3] * v[j][3]; }
        const float r = rsqrtf(wave_sum(ss) * (1.f / D) + EPS);
        const float* mr = modl + (size_t)modrow(tok) * NMODC;
#pragma unroll
        for (int j = 0; j < 4; ++j) {
            const int k = lane * 4 + 256 * j;
            const f32x4 gv = *(const f32x4*)(g + k), sc = *(const f32x4*)(mr + scale_chunk * 1024 + k), sh = *(const f32x4*)(mr + shift_chunk * 1024 + k);
            f32x4 h;
#pragma unroll
            for (int e = 0; e < 4; ++e) h[e] = v[j][e] * r * gv[e] * (1.f + sc[e]) + sh[e];
            *(u32x2*)(H + (size_t)tok * D + k) = pack4(h);
        }
    }
}
__device__ __forceinline__ void phase_final(const float* __restrict__ X, const float* __restrict__ g, float* __restrict__ out) {
    const int tid_ = tid_opaque(); const int lane = tid_ & 63, gw = bid_opaque() * 8 + (tid_ >> 6), nW = gridDim.x * 8;
#pragma unroll 4
    for (int tok = gw; tok < NTOK; tok += nW) {
        const float* xr = X + (size_t)tok * D + lane * 4;
        f32x4 v[4]; float ss = 0.f;
#pragma unroll
        for (int j = 0; j < 4; ++j) { v[j] = *(const f32x4*)(xr + 256 * j); ss += v[j][0] * v[j][0] + v[j][1] * v[j][1] + v[j][2] * v[j][2] + v[j][3] * v[j][3]; }
        const float r = rsqrtf(wave_sum(ss) * (1.f / D) + EPS);
#pragma unroll
        for (int j = 0; j < 4; ++j) {
            const int k = lane * 4 + 256 * j;
            const f32x4 gv = *(const f32x4*)(g + k);
            f32x4 h;
#pragma unroll
            for (int e = 0; e < 4; ++e) h[e] = v[j][e] * r * gv[e];
            *(f32x4*)(out + (size_t)tok * D + k) = h;
        }
    }
}

struct EpiSwiGLU {
    bf16_t* U;
    __device__ __forceinline__ void operator()(f32x4 (&acc)[4][4], int row0, int col0, int fr, int fq) const {
        const int j0 = (col0 >> 6) * 32;
#pragma unroll
        for (int mt = 0; mt < 4; ++mt) {
            const int row = row0 + mt * 16 + fr;
#pragma unroll
            for (int h = 0; h < 2; ++h) {
                f32x4 o;
#pragma unroll
                for (int e = 0; e < 4; ++e) o[e] = silu_f(acc[mt][h][e]) * acc[mt][h + 2][e];
                *(u32x2*)(U + (size_t)row * DFF + j0 + h * 16 + fq * 4) = pack4(o);
            }
        }
    }
};
struct EpiResid {
    float* X; const float* gate; float s;
    __device__ __forceinline__ void operator()(f32x4 (&acc)[4][4], int row0, int col0, int fr, int fq) const {
        const float* gr = gate + (size_t)modrow(row0) * NMODC + col0 + fq * 4;
        float* xp0 = X + (size_t)(row0 + fr) * D + col0 + fq * 4;
        f32x4 gv[4], x[4][4];
#pragma unroll
        for (int nt = 0; nt < 4; ++nt) gv[nt] = *(const f32x4*)(gr + nt * 16);
#pragma unroll
        for (int mt = 0; mt < 4; ++mt)
#pragma unroll
            for (int nt = 0; nt < 4; ++nt) x[mt][nt] = *(const f32x4*)(xp0 + (size_t)(mt * 16) * D + nt * 16);
        asm volatile("" ::: "memory");
#pragma unroll
        for (int mt = 0; mt < 4; ++mt)
#pragma unroll
            for (int nt = 0; nt < 4; ++nt) {
#pragma unroll
                for (int e = 0; e < 4; ++e) x[mt][nt][e] += s * gv[nt][e] * acc[mt][nt][e];
                *(f32x4*)(xp0 + (size_t)(mt * 16) * D + nt * 16) = x[mt][nt];
            }
    }
};
struct EpiF32 {
    float* C; int ldc, ncols;
    __device__ __forceinline__ void operator()(f32x4 (&acc)[4][4], int row0, int col0, int fr, int fq) const {
#pragma unroll
        for (int mt = 0; mt < 4; ++mt)
#pragma unroll
            for (int nt = 0; nt < 4; ++nt) {
                const int row = row0 + mt * 16 + fr, col = col0 + nt * 16 + fq * 4;
                if (col < ncols) *(f32x4*)(C + (size_t)row * ldc + col) = acc[mt][nt];
            }
    }
};
struct EpiBf16 {
    bf16_t* C; int ldc;
    __device__ __forceinline__ void operator()(f32x4 (&acc)[4][4], int row0, int col0, int fr, int fq) const {
#pragma unroll
        for (int mt = 0; mt < 4; ++mt)
#pragma unroll
            for (int nt = 0; nt < 4; ++nt) {
                const int row = row0 + mt * 16 + fr, col = col0 + nt * 16 + fq * 4;
                *(u32x2*)(C + (size_t)row * ldc + col) = pack4(acc[mt][nt]);
            }
    }
};
struct EpiBf16T {
    bf16_t* C; int ldc;
    __device__ __forceinline__ void operator()(f32x4 (&acc)[4][4], int row0, int col0, int fr, int fq) const {
#pragma unroll
        for (int mt = 0; mt < 4; ++mt)
#pragma unroll
            for (int nt = 0; nt < 4; ++nt) {
                const int row = row0 + mt * 16 + fr, col = col0 + nt * 16 + fq * 4;
                *(u32x2*)(C + (size_t)row * ldc + col) = pack4(acc[mt][nt]);
            }
    }
};
struct EpiSSMIn {
    bf16_t* ZXB; float* DTRAW;
    __device__ __forceinline__ void operator()(f32x4 (&acc)[4][4], int row0, int col0, int fr, int fq) const {
#pragma unroll
        for (int mt = 0; mt < 4; ++mt)
#pragma unroll
            for (int nt = 0; nt < 4; ++nt) {
                const int row = row0 + mt * 16 + fr, col = col0 + nt * 16 + fq * 4;
                if (col < 5120) *(u32x2*)(ZXB + (size_t)row * 5120 + col) = pack4(acc[mt][nt]);
                else if (col < 5184) *(f32x4*)(DTRAW + (size_t)row * 64 + (col - 5120)) = acc[mt][nt];
            }
    }
};
struct EpiQ {
    bf16_t* Q; const float* rope; float qscale;
    __device__ __forceinline__ void operator()(f32x4 (&acc)[4][4], int row0, int col0, int fr, int fq) const {
#pragma unroll
        for (int mt = 0; mt < 4; ++mt) {
            const int row = row0 + mt * 16 + fr;
            const int pos = (row - 4096) & 2047;
#pragma unroll
            for (int nt = 0; nt < 4; ++nt) {
                const int c16 = col0 + nt * 16, d16 = c16 % 96;
                f32x4 v = acc[mt][nt];
                if (row0 >= 4096 && d16 >= 64) {
                    const int axis = (d16 - 64) >> 4, ph = fq >> 1, f0 = (fq & 1) * 4;
                    f32x4 pr;
#pragma unroll
                    for (int e = 0; e < 4; ++e) pr[e] = __shfl_xor(v[e], 32);
                    const f32x4 cs = *(const f32x4*)(rope + pos * 32 + axis * 8 + f0), sn = *(const f32x4*)(rope + pos * 32 + 16 + axis * 8 + f0);
#pragma unroll
                    for (int e = 0; e < 4; ++e) v[e] = ph == 0 ? v[e] * cs[e] - pr[e] * sn[e] : v[e] * cs[e] + pr[e] * sn[e];
                }
#pragma unroll
                for (int e = 0; e < 4; ++e) v[e] *= qscale;
                *(u32x2*)(Q + (size_t)row * 1536 + c16 + fq * 4) = pack4(v);
            }
        }
    }
};

template <class Epi>
__device__ __forceinline__ void gemm_tiles(const bf16_t* A, int lda, const bf16_t* Bt, int ldb, int M, int N, int K, const Epi& epi, unsigned char* smem, int rot) {
    constexpr int AS = 72;
    bf16_t* As = (bf16_t*)smem;
    bf16_t* Bs = As + 2 * 256 * AS;
    const int tid = tid_opaque(), wid = __builtin_amdgcn_readfirstlane(tid >> 6), lane = tid & 63, fr = lane & 15, fq = lane >> 4;
    const int wm = wid >> 1, wn = wid & 1;
    const int nM = M >> 8, nN = N >> 7, nT = nM * nN, nk = K >> 6;
    const int G = gridDim.x;
    const int b = (bid_opaque() + G - (rot % G)) % G;
    const int lr = tid >> 3, lc = (tid & 7) * 8;
    for (int t = b; t < nT; t += G) {
        const int tn = t / nM, tm = t % nM;
        const bf16_t* Ag = A + (size_t)(tm * 256 + lr) * lda + lc;
        const bf16_t* Bg = Bt + (size_t)(tn * 128 + lr) * ldb + lc;
        __syncthreads();
        f32x4 acc[4][4];
#pragma unroll
        for (int i = 0; i < 4; ++i)
#pragma unroll
            for (int j = 0; j < 4; ++j) acc[i][j] = (f32x4){0.f, 0.f, 0.f, 0.f};
        u32x4 ra0[4], rb0[2], ra1[4], rb1[2];
#define G_LOAD(RA, RB, kt_) { _Pragma("unroll") for (int i = 0; i < 4; ++i) RA[i] = *(const u32x4*)(Ag + (size_t)(64 * i) * lda + (kt_) * 64); \
                              _Pragma("unroll") for (int i = 0; i < 2; ++i) RB[i] = *(const u32x4*)(Bg + (size_t)(64 * i) * ldb + (kt_) * 64); }
#define G_STORE(RA, RB, buf_) { _Pragma("unroll") for (int i = 0; i < 4; ++i) *(u32x4*)(As + ((buf_) * 256 + lr + 64 * i) * AS + lc) = RA[i]; \
                                _Pragma("unroll") for (int i = 0; i < 2; ++i) *(u32x4*)(Bs + ((buf_) * 128 + lr + 64 * i) * AS + lc) = RB[i]; }
#define G_COMPUTE(cur_) { const bf16_t* Ac = As + ((cur_) * 256 + wm * 64 + fr) * AS + fq * 8; const bf16_t* Bc = Bs + ((cur_) * 128 + wn * 64 + fr) * AS + fq * 8; \
            _Pragma("unroll") for (int ks = 0; ks < 2; ++ks) { bf16x8 af[4], bfr[4]; \
                _Pragma("unroll") for (int mt = 0; mt < 4; ++mt) af[mt] = *(const bf16x8*)(Ac + mt * 16 * AS + ks * 32); \
                _Pragma("unroll") for (int nt = 0; nt < 4; ++nt) bfr[nt] = *(const bf16x8*)(Bc + nt * 16 * AS + ks * 32); \
                _Pragma("unroll") for (int mt = 0; mt < 4; ++mt) _Pragma("unroll") for (int nt = 0; nt < 4; ++nt) acc[mt][nt] = mfma16(bfr[nt], af[mt], acc[mt][nt]); } }
        G_LOAD(ra0, rb0, 0);
        G_LOAD(ra1, rb1, 1);
        G_STORE(ra0, rb0, 0);
        __syncthreads();
        for (int kt = 0; kt < nk; kt += 2) {
            { const int k2 = kt + 2 < nk ? kt + 2 : kt; G_LOAD(ra0, rb0, k2); }
            G_COMPUTE(0);
            G_STORE(ra1, rb1, 1);
            __syncthreads();
            { const int k3 = kt + 3 < nk ? kt + 3 : kt + 1; G_LOAD(ra1, rb1, k3); }
            G_COMPUTE(1);
            if (kt + 2 < nk) G_STORE(ra0, rb0, 0);
            __syncthreads();
        }
#undef G_LOAD
#undef G_STORE
#undef G_COMPUTE
        epi(acc, tm * 256 + wm * 64, tn * 128 + wn * 64, fr, fq);
    }
}


namespace pg8 {
#define PG8_LAS __attribute__((address_space(3)))
constexpr int BM = 256, BK = 64, HALF = 128, HTB = HALF * BK * 2, NXCD = 8, WGM = 8;
__device__ __forceinline__ int lds_byte(int r, int c) { const int st = (r >> 4) * 2 + (c >> 5), rr = r & 15, cc = c & 31, ob = rr * 64 + cc * 2; return st * 1024 + (ob ^ (((ob >> 9) & 1) << 5)); }
__device__ __forceinline__ void stage_rc(int b, int& R, int& C) { const int st = b / 1024, sb = b % 1024, swz = sb ^ (((sb >> 9) & 1) << 5); R = (st >> 1) * 16 + swz / 64; C = (st & 1) * 32 + (swz % 64) / 2; }
__device__ __forceinline__ int perm32(int rho) { const int n = rho >> 4, i = rho & 15; return 8 * (i >> 2) + 4 * n + (i & 3); }
struct Unit { int pm, pn; };
struct StaticOrder {
    int nM, nN, nwg, G, c;
    __device__ void init(int M, int N, int G_, int c_) { nM = M / BM; nN = N / BM; nwg = nM * nN; G = G_; c = c_; }
    __device__ bool next(int i, Unit& u) const {
        const long L = (long)i * G + c; if (L >= nwg) return false;
        int wgid = (int)L; { const int q = nwg / NXCD, r = nwg % NXCD, xcd = wgid % NXCD, off = wgid / NXCD; wgid = (xcd < r ? xcd * (q + 1) : r * (q + 1) + (xcd - r) * q) + off; }
        const int nig = WGM * nN, gid = wgid / nig, fm = gid * WGM, gsz = (nM - fm) < WGM ? (nM - fm) : WGM;
        u.pm = fm + ((wgid % nig) % gsz); u.pn = (wgid % nig) / gsz; return true;
    }
};
template <class Epi, class Sched>
__device__ __forceinline__ void gemm_phase(PG8_LAS unsigned char* lds, const bf16_t* A, const bf16_t* Bt, int K, const Sched& S, const Epi& E) {
    const int tid = tid_opaque(), wid = __builtin_amdgcn_readfirstlane(tid >> 6), lane = tid & 63, wr = wid >> 2, wc = wid & 3, fr = lane & 15, fq = lane >> 4;
    const int nt = K / BK;
    unsigned voffA[2], voffB[2];
#pragma unroll
    for (int i = 0; i < 2; ++i) { int R, C; stage_rc(tid * 16 + i * 8192, R, C); const int Rb = Epi::PERM ? ((R & ~31) + perm32(R & 31)) : R;
        voffA[i] = (unsigned)(R * K + C) * 2u; voffB[i] = (unsigned)(Rb * K + C) * 2u; }
    const size_t kstep = (size_t)(BK * 2);
    const size_t hstep = (size_t)HALF * K * 2;
    const size_t tstep = 2 * hstep;
    const unsigned ldsw = (unsigned)wid * 1024u;
    const int aoff = lds_byte(wr * 64 + fr, fq * 8), boff = lds_byte(wc * 32 + fr, fq * 8);
#define PG8_SA(b, h) (((b) * 2 + (h)) * HTB)
#define PG8_SB(b, h) ((4 + (b) * 2 + (h)) * HTB)
#define PG8_STAGE(bufoff, gbase, voff) do { _Pragma("unroll") for (int _i = 0; _i < 2; ++_i) \
        __builtin_amdgcn_global_load_lds((const unsigned*)((const char*)(gbase) + (voff)[_i]), (PG8_LAS unsigned*)(lds + (bufoff) + ldsw + _i * 8192), 16, 0, 0); } while (0)
#define PG8_LDA(dst, b, h) do { _Pragma("unroll") for (int m = 0; m < 4; ++m) _Pragma("unroll") for (int k = 0; k < 2; ++k) dst[m][k] = *(const PG8_LAS bf16x8*)(lds + PG8_SA(b, h) + aoff + m * 2048 + k * 1024); } while (0)
#define PG8_LDB(dst, b, h) do { _Pragma("unroll") for (int n = 0; n < 2; ++n) _Pragma("unroll") for (int k = 0; k < 2; ++k) dst[n][k] = *(const PG8_LAS bf16x8*)(lds + PG8_SB(b, h) + boff + n * 2048 + k * 1024); } while (0)
#define PG8_MMA(ai, bj, At, Bt) do { __builtin_amdgcn_s_setprio(1); _Pragma("unroll") for (int m = 0; m < 4; ++m) _Pragma("unroll") for (int n = 0; n < 2; ++n) _Pragma("unroll") for (int k = 0; k < 2; ++k) \
        acc[ai][bj][m][n] = __builtin_amdgcn_mfma_f32_16x16x32_bf16(Bt[n][k], At[m][k], acc[ai][bj][m][n], 0, 0, 0); __builtin_amdgcn_s_setprio(0); } while (0)
#define PG8_WAIT_V(n) asm volatile("s_waitcnt vmcnt(" #n ")" ::: "memory")
#define PG8_WAIT_L(n) asm volatile("s_waitcnt lgkmcnt(" #n ")" ::: "memory")
#define PG8_BAR __builtin_amdgcn_s_barrier()
#define PG8_SCHED __builtin_amdgcn_sched_barrier(0)
    Unit cur, nxt; int ui = 0;
    if (!S.next(0, cur)) return;
    f32x4 acc[2][2][4][2];
#pragma unroll
    for (int a = 0; a < 2; ++a)
#pragma unroll
        for (int b = 0; b < 2; ++b)
#pragma unroll
            for (int m = 0; m < 4; ++m)
#pragma unroll
                for (int n = 0; n < 2; ++n) acc[a][b][m][n] = (f32x4){0.f, 0.f, 0.f, 0.f};
    bf16x8 At[4][2], B0[2][2], B1[2][2];
    const char* cA = (const char*)A + (size_t)cur.pm * tstep; const char* cB = (const char*)Bt + (size_t)cur.pn * tstep;
    PG8_STAGE(PG8_SB(0, 0), cB, voffB); PG8_STAGE(PG8_SA(0, 0), cA, voffA); PG8_STAGE(PG8_SB(0, 1), cB + hstep, voffB); PG8_STAGE(PG8_SA(0, 1), cA + hstep, voffA);
    if (wr == 1) PG8_BAR;
    PG8_WAIT_V(4); PG8_BAR;
    PG8_STAGE(PG8_SB(1, 0), cB + kstep, voffB); PG8_STAGE(PG8_SA(1, 0), cA + kstep, voffA); PG8_STAGE(PG8_SB(1, 1), cB + hstep + kstep, voffB);
    PG8_WAIT_V(6); PG8_BAR;
    for (;;) {
        const bool has_next = S.next(ui + 1, nxt);
        const char* nA = has_next ? (const char*)A + (size_t)nxt.pm * tstep : cA; const char* nB = has_next ? (const char*)Bt + (size_t)nxt.pn * tstep : cB;
        for (int t = 0; t < nt; t += 2) {
            const bool last = (t == nt - 2);
            const char* a1 = cA + (size_t)(t + 1) * kstep;
            const char* a2 = last ? nA : cA + (size_t)(t + 2) * kstep; const char* b2 = last ? nB : cB + (size_t)(t + 2) * kstep;
            const char* a3 = a2 + kstep; const char* b3 = b2 + kstep;
            PG8_LDB(B0, 0, 0); PG8_SCHED; PG8_LDA(At, 0, 0); PG8_STAGE(PG8_SA(1, 1), a1 + hstep, voffA);
            PG8_WAIT_L(8); PG8_BAR; PG8_WAIT_L(0); PG8_MMA(0, 0, At, B0); PG8_BAR; PG8_SCHED;
            PG8_LDB(B1, 0, 1); PG8_STAGE(PG8_SB(0, 0), b2, voffB);
            PG8_BAR; PG8_WAIT_L(0); PG8_MMA(0, 1, At, B1); PG8_BAR;
            PG8_LDA(At, 0, 1); PG8_STAGE(PG8_SA(0, 0), a2, voffA);
            PG8_BAR; PG8_WAIT_L(0); PG8_MMA(1, 0, At, B0); PG8_BAR; PG8_SCHED;
            PG8_STAGE(PG8_SB(0, 1), b2 + hstep, voffB);
            PG8_WAIT_V(6); PG8_BAR; PG8_MMA(1, 1, At, B1); PG8_BAR;
            PG8_LDB(B0, 1, 0); PG8_SCHED; PG8_LDA(At, 1, 0); PG8_STAGE(PG8_SA(0, 1), a2 + hstep, voffA);
            PG8_WAIT_L(8); PG8_BAR; PG8_WAIT_L(0); PG8_MMA(0, 0, At, B0); PG8_BAR; PG8_SCHED;
            PG8_LDB(B1, 1, 1); PG8_STAGE(PG8_SB(1, 0), b3, voffB);
            PG8_BAR; PG8_WAIT_L(0); PG8_MMA(0, 1, At, B1); PG8_BAR;
            PG8_LDA(At, 1, 1); PG8_STAGE(PG8_SA(1, 0), a3, voffA);
            PG8_BAR; PG8_WAIT_L(0); PG8_MMA(1, 0, At, B0); PG8_BAR; PG8_SCHED;
            PG8_STAGE(PG8_SB(1, 1), b3 + hstep, voffB);
            PG8_WAIT_V(6); PG8_BAR; PG8_MMA(1, 1, At, B1); PG8_BAR;
        }
        E(acc, cur, wr, wc, fr, fq);
        if (!has_next) break;
#pragma unroll
        for (int a = 0; a < 2; ++a)
#pragma unroll
            for (int b = 0; b < 2; ++b)
#pragma unroll
                for (int m = 0; m < 4; ++m)
#pragma unroll
                    for (int n = 0; n < 2; ++n) acc[a][b][m][n] = (f32x4){0.f, 0.f, 0.f, 0.f};
        cur = nxt; cA = nA; cB = nB; ++ui;
    }
    PG8_WAIT_V(0);
    if (wr == 0) PG8_BAR;
    PG8_BAR;
#undef PG8_SA
#undef PG8_SB
#undef PG8_STAGE
#undef PG8_LDA
#undef PG8_LDB
#undef PG8_MMA
#undef PG8_WAIT_V
#undef PG8_WAIT_L
#undef PG8_BAR
#undef PG8_SCHED
}
}

struct Epi8SwiGLU {
    static constexpr bool PERM = false;
    bf16_t* U;
    __device__ __forceinline__ void operator()(const f32x4 (&acc)[2][2][4][2], const pg8::Unit& u, int wr, int wc, int fr, int fq) const {
#pragma unroll
        for (int ai = 0; ai < 2; ++ai)
#pragma unroll
            for (int m = 0; m < 4; ++m) {
                const int row = u.pm * 256 + ai * 128 + wr * 64 + m * 16 + fr;
#pragma unroll
                for (int n = 0; n < 2; ++n) {
                    f32x4 o;
#pragma unroll
                    for (int e = 0; e < 4; ++e) o[e] = silu_f(acc[ai][0][m][n][e]) * acc[ai][1][m][n][e];
                    *(u32x2*)(U + (size_t)row * DFF + u.pn * 128 + wc * 32 + n * 16 + fq * 4) = pack4(o);
                }
            }
    }
};
struct Epi8SSMIn {
    static constexpr bool PERM = false;
    bf16_t* ZXB; float* DTRAW;
    __device__ __forceinline__ void operator()(const f32x4 (&acc)[2][2][4][2], const pg8::Unit& u, int wr, int wc, int fr, int fq) const {
#pragma unroll
        for (int ai = 0; ai < 2; ++ai)
#pragma unroll
            for (int m = 0; m < 4; ++m) {
                const int row = u.pm * 256 + ai * 128 + wr * 64 + m * 16 + fr;
#pragma unroll
                for (int bj = 0; bj < 2; ++bj)
#pragma unroll
                    for (int n = 0; n < 2; ++n) {
                        const int col = u.pn * 256 + bj * 128 + wc * 32 + n * 16 + fq * 4;
                        if (col < 5120) *(u32x2*)(ZXB + (size_t)row * 5120 + col) = pack4(acc[ai][bj][m][n]);
                        else if (col < 5184) *(f32x4*)(DTRAW + (size_t)row * 64 + (col - 5120)) = acc[ai][bj][m][n];
                    }
            }
    }
};

__device__ __forceinline__ void phase_mlanorm(const float* __restrict__ QKVA, const float* __restrict__ qn, const float* __restrict__ kvn, const float* __restrict__ cache, int j,
                              const float* __restrict__ rope, bf16_t* __restrict__ QA, bf16_t* __restrict__ CKV, bf16_t* __restrict__ KR, float* __restrict__ out_cache) {
    const int tid_ = tid_opaque(); const int lane = tid_ & 63, gw = bid_opaque() * 8 + (tid_ >> 6), nW = gridDim.x * 8;
    for (int tok = gw; tok < NTOKKV; tok += nW) {
        if (tok < NTOK) {
            const float* r = QKVA + (size_t)tok * 800;
            const f32x4 q0 = *(const f32x4*)(r + lane * 4), q1 = *(const f32x4*)(r + 256 + lane * 4), kv = *(const f32x4*)(r + 512 + lane * 4);
            const float kr = lane < 32 ? r[768 + lane] : 0.f;
            float sq = 0.f, sk = 0.f;
#pragma unroll
            for (int e = 0; e < 4; ++e) { sq += q0[e] * q0[e] + q1[e] * q1[e]; sk += kv[e] * kv[e]; }
            const float rq = rsqrtf(wave_sum(sq) * (1.f / 512) + EPS), rk = rsqrtf(wave_sum(sk) * (1.f / 256) + EPS);
            const f32x4 g0 = *(const f32x4*)(qn + lane * 4), g1 = *(const f32x4*)(qn + 256 + lane * 4), gk = *(const f32x4*)(kvn + lane * 4);
            f32x4 a0, a1, ck;
#pragma unroll
            for (int e = 0; e < 4; ++e) { a0[e] = q0[e] * rq * g0[e]; a1[e] = q1[e] * rq * g1[e]; ck[e] = kv[e] * rk * gk[e]; }
            *(u32x2*)(QA + (size_t)tok * 512 + lane * 4) = pack4(a0);
            *(u32x2*)(QA + (size_t)tok * 512 + 256 + lane * 4) = pack4(a1);
            *(u32x2*)(CKV + (size_t)tok * 256 + lane * 4) = pack4(ck);
            float krv = kr;
            if (tok < 4096) {
                float* o = out_cache + ((size_t)((tok >> 8) * 2 + j) * 256 + (tok & 255)) * 288;
                *(f32x4*)(o + lane * 4) = ck;
                if (lane < 32) o[256 + lane] = kr;
            } else {
                const int pos = (tok - 4096) & 2047;
                const float partner = __shfl_xor(kr, 8);
                const int l31 = lane & 31, axis = l31 >> 4, ph = (l31 >> 3) & 1, f = l31 & 7;
                const float cs = rope[pos * 32 + axis * 8 + f], sn = rope[pos * 32 + 16 + axis * 8 + f];
                krv = ph == 0 ? kr * cs - partner * sn : kr * cs + partner * sn;
            }
            if (lane < 32) KR[(size_t)tok * 32 + lane] = f2bf(krv);
        } else {
            const int ct = tok - NTOK, bb = ct >> 8, pp = ct & 255;
            const float* c = cache + ((size_t)(bb * 2 + j) * 256 + pp) * 288;
            const f32x4 kv = *(const f32x4*)(c + lane * 4);
            *(u32x2*)(CKV + (size_t)tok * 256 + lane * 4) = pack4(kv);
            if (lane < 32) KR[(size_t)tok * 32 + lane] = f2bf(c[256 + lane]);
        }
    }
}

__device__ __forceinline__ void phase_attn(const bf16_t* __restrict__ Q, const bf16_t* __restrict__ KN, const bf16_t* __restrict__ KR, const bf16_t* __restrict__ VT, bf16_t* __restrict__ O, unsigned char* smem) {
    constexpr int KS = 104, VS = 72;
    bf16_t* Ks = (bf16_t*)smem;
    bf16_t* Vs = Ks + 2 * 64 * KS;
    const int tid = tid_opaque(), wid = __builtin_amdgcn_readfirstlane(tid >> 6), lane = tid & 63, fr = lane & 15, fq = lane >> 4;
    const int G = gridDim.x, b = bid_opaque();
    const int lrow = tid >> 3, lc8 = (tid & 7) * 8, rrow = (tid >> 2) & 63, rc8 = (tid & 3) * 8;
    for (int it = 0;; ++it) {
        const int idx = (it >> 1) * G + b;
        if (idx >= 256) break;
        const bool samp = (it & 1) == 0;
        int head, q0, nkt, sb = 0, kbase = 0;
        if (samp) { sb = idx >> 7; const int rem = idx & 127; head = rem >> 3; q0 = 4096 + sb * 2048 + (rem & 7) * 256; nkt = 36; }
        else { const int seq = idx >> 4; head = idx & 15; q0 = seq * 256; nkt = 4; kbase = seq * 256; }
        bf16x8 qf[2][3];
#pragma unroll
        for (int g = 0; g < 2; ++g)
#pragma unroll
            for (int ks = 0; ks < 3; ++ks) qf[g][ks] = *(const bf16x8*)(Q + (size_t)(q0 + wid * 32 + g * 16 + fr) * 1536 + head * 96 + ks * 32 + fq * 8);
        f32x4 ot[2][4];
#pragma unroll
        for (int g = 0; g < 2; ++g)
#pragma unroll
            for (int i = 0; i < 4; ++i) ot[g][i] = (f32x4){0.f, 0.f, 0.f, 0.f};
        float m[2] = {-1e30f, -1e30f}, l[2] = {0.f, 0.f};
        u32x4 rk, rr = {0u, 0u, 0u, 0u}, rv;
#define ATT_TB(kt) (samp ? ((kt) < 4 ? NTOK + sb * 256 + (kt) * 64 : 4096 + sb * 2048 + ((kt) - 4) * 64) : kbase + (kt) * 64)
#define ATT_GLOAD(kt) { const int tb = ATT_TB(kt); rk = *(const u32x4*)(KN + (size_t)(tb + lrow) * 1024 + head * 64 + lc8); \
            if (tid < 256) rr = *(const u32x4*)(KR + (size_t)(tb + rrow) * 32 + rc8); \
            rv = *(const u32x4*)(VT + (size_t)(head * 64 + lrow) * NTOKKV + tb + lc8); }
#define ATT_LSTORE(buf) { *(u32x4*)(Ks + ((buf) * 64 + lrow) * KS + lc8) = rk; if (tid < 256) *(u32x4*)(Ks + ((buf) * 64 + rrow) * KS + 64 + rc8) = rr; \
            *(u32x4*)(Vs + ((buf) * 64 + lrow) * VS + lc8) = rv; }
        ATT_GLOAD(0); ATT_LSTORE(0);
        __syncthreads();
#pragma unroll 1
        for (int kt = 0; kt < nkt; ++kt) {
            const int cur = kt & 1;
            if (kt + 1 < nkt) ATT_GLOAD(kt + 1);
            f32x4 st[2][4];
            __builtin_amdgcn_s_setprio(1);
#pragma unroll
            for (int jt = 0; jt < 4; ++jt) {
                st[0][jt] = (f32x4){0.f, 0.f, 0.f, 0.f}; st[1][jt] = (f32x4){0.f, 0.f, 0.f, 0.f};
#pragma unroll
                for (int ks = 0; ks < 3; ++ks) {
                    const bf16x8 a = *(const bf16x8*)(Ks + (cur * 64 + jt * 16 + fr) * KS + ks * 32 + fq * 8);
                    st[0][jt] = mfma16(a, qf[0][ks], st[0][jt]);
                    st[1][jt] = mfma16(a, qf[1][ks], st[1][jt]);
                }
                asm volatile("" ::: "memory");
            }
            __builtin_amdgcn_s_setprio(0);
            union { u32x4 u; bf16x8 v; } pb[2][2];
#pragma unroll
            for (int g = 0; g < 2; ++g) {
                float mloc = st[g][0][0];
#pragma unroll
                for (int jt = 0; jt < 4; ++jt)
#pragma unroll
                    for (int e = 0; e < 4; ++e) mloc = fmaxf(mloc, st[g][jt][e]);
                mloc = fmaxf(mloc, __shfl_xor(mloc, 16)); mloc = fmaxf(mloc, __shfl_xor(mloc, 32));
                const float mn = fmaxf(m[g], mloc), alpha = __builtin_amdgcn_exp2f(m[g] - mn);
                m[g] = mn;
                float psum = 0.f;
#pragma unroll
                for (int jt = 0; jt < 4; ++jt)
#pragma unroll
                    for (int e = 0; e < 4; ++e) { st[g][jt][e] = __builtin_amdgcn_exp2f(st[g][jt][e] - mn); psum += st[g][jt][e]; }
                l[g] = l[g] * alpha + psum;
#pragma unroll
                for (int i = 0; i < 4; ++i) ot[g][i] *= alpha;
#pragma unroll
                for (int s = 0; s < 2; ++s) {
                    pb[g][s].u.x = pk2(st[g][2 * s][0], st[g][2 * s][1]); pb[g][s].u.y = pk2(st[g][2 * s][2], st[g][2 * s][3]);
                    pb[g][s].u.z = pk2(st[g][2 * s + 1][0], st[g][2 * s + 1][1]); pb[g][s].u.w = pk2(st[g][2 * s + 1][2], st[g][2 * s + 1][3]);
                }
            }
            __builtin_amdgcn_s_setprio(1);
#pragma unroll
            for (int s = 0; s < 2; ++s)
#pragma unroll
                for (int dvt = 0; dvt < 4; ++dvt) {
                    const bf16_t* vp = Vs + (cur * 64 + dvt * 16 + fr) * VS + s * 32 + fq * 4;
                    union { u32x4 u; bf16x8 v; } va;
                    const u32x2 lo = *(const u32x2*)vp, hi = *(const u32x2*)(vp + 16);
                    va.u.x = lo.x; va.u.y = lo.y; va.u.z = hi.x; va.u.w = hi.y;
                    ot[0][dvt] = mfma16(va.v, pb[0][s].v, ot[0][dvt]);
                    ot[1][dvt] = mfma16(va.v, pb[1][s].v, ot[1][dvt]);
                    asm volatile("" ::: "memory");
                }
            __builtin_amdgcn_s_setprio(0);
            if (kt + 1 < nkt) ATT_LSTORE(cur ^ 1);
            __syncthreads();
        }
#pragma unroll
        for (int g = 0; g < 2; ++g) {
            float lt = l[g];
            lt += __shfl_xor(lt, 16); lt += __shfl_xor(lt, 32);
            const float inv = 1.f / lt;
#pragma unroll
            for (int dvt = 0; dvt < 4; ++dvt) {
                f32x4 o = ot[g][dvt] * inv;
                *(u32x2*)(O + (size_t)(q0 + wid * 32 + g * 16 + fr) * 1024 + head * 64 + dvt * 16 + fq * 4) = pack4(o);
            }
        }
    }
#undef ATT_TB
#undef ATT_GLOAD
#undef ATT_LSTORE
}


__device__ __forceinline__ void phase_conv(const bf16_t* __restrict__ ZXB, const float* __restrict__ DTRAW, const float* __restrict__ cw, const float* __restrict__ cb, const float* __restrict__ dtb,
                           bf16_t* __restrict__ XS, bf16_t* __restrict__ XT, bf16_t* __restrict__ BM, bf16_t* __restrict__ BT, bf16_t* __restrict__ CM, float* __restrict__ DT, unsigned char* smem) {
    float* in = (float*)smem;
    bf16_t* ot = (bf16_t*)(smem + 34560);
    const int tid = tid_opaque(), G = gridDim.x;
    u32x4 pv[3];
#define CONV_LOAD(item_) { const int chunk_ = (item_) / 48, slab_ = (item_) % 48, t0_ = chunk_ * 128; int lo_, hi_; \
        if (chunk_ < 32) { lo_ = (chunk_ >> 1) * 256; hi_ = lo_ + 256; } else { lo_ = 4096 + ((chunk_ - 32) >> 4) * 2048; hi_ = lo_ + 2048; } \
        _Pragma("unroll") for (int k = 0; k < 3; ++k) { const int c = tid + k * NT, r = c >> 3, kc = c & 7, t = t0_ - 2 + r; pv[k] = (u32x4){0u, 0u, 0u, 0u}; \
            if (c < 132 * 8 && t >= lo_ && t < hi_) pv[k] = *(const u32x4*)(ZXB + (size_t)t * 5120 + 2048 + slab_ * 64 + kc * 8); } }
    const int item0 = bid_opaque();
    if (item0 < 64 * 48) CONV_LOAD(item0);
    for (int item = item0; item < 64 * 48; item += G) {
        const int chunk = item / 48, slab = item % 48, t0 = chunk * 128;
#pragma unroll
        for (int k = 0; k < 3; ++k) {
            const int c = tid + k * NT, r = c >> 3, kc = c & 7;
            if (c < 132 * 8) {
                const u32x4 v = pv[k];
                float* d = in + r * 65 + kc * 8;
                d[0] = bflo(v.x); d[1] = bfhi(v.x); d[2] = bflo(v.y); d[3] = bfhi(v.y); d[4] = bflo(v.z); d[5] = bfhi(v.z); d[6] = bflo(v.w); d[7] = bfhi(v.w);
            }
        }
        __syncthreads();
        if (item + G < 64 * 48) CONV_LOAD(item + G);
        {
            const int ch = tid & 63, tg = tid >> 6, cg_ = slab * 64 + ch;
            const float w0 = cw[cg_], w1 = cw[3072 + cg_], w2 = cw[2 * 3072 + cg_], w3 = cw[3 * 3072 + cg_], w4 = cw[4 * 3072 + cg_], bias = cb[cg_];
            const float* ip = in + (tg * 16) * 65 + ch;
            float x0 = ip[0], x1 = ip[65], x2 = ip[130], x3 = ip[195];
#pragma unroll
            for (int tt = 0; tt < 16; ++tt) {
                const float x4 = ip[(tt + 4) * 65];
                const float a = bias + x0 * w0 + x1 * w1 + x2 * w2 + x3 * w3 + x4 * w4;
                ot[(tg * 16 + tt) * 66 + ch] = f2bf(silu_f(a));
                x0 = x1; x1 = x2; x2 = x3; x3 = x4;
            }
        }
        __syncthreads();
        bf16_t* dst; int ld, col; bf16_t* tdst = nullptr;
        if (slab < 32) { dst = XS; ld = 2048; col = slab * 64; tdst = XT + ((size_t)chunk * 2048 + slab * 64) * 128; }
        else if (slab < 40) { dst = BM; ld = 512; col = (slab - 32) * 64; tdst = BT + ((size_t)chunk * 512 + (slab - 32) * 64) * 128; }
        else { dst = CM; ld = 512; col = (slab - 40) * 64; }
#pragma unroll
        for (int i = 0; i < 2; ++i) {
            const int c = tid + i * NT, r = c >> 3, kc = c & 7;
            const unsigned* s32 = (const unsigned*)ot + r * 33 + kc * 4;
            u32x4 o; o.x = s32[0]; o.y = s32[1]; o.z = s32[2]; o.w = s32[3];
            *(u32x4*)(dst + (size_t)(t0 + r) * ld + col + kc * 8) = o;
        }
        if (tdst) {
#pragma unroll
            for (int i = 0; i < 2; ++i) {
                const int c = tid + i * NT, chh = c >> 4, jc = c & 15;
                const bf16_t* s = ot + (jc * 8) * 66 + chh;
                u32x4 o;
                o.x = (unsigned)s[0] | ((unsigned)s[66] << 16); o.y = (unsigned)s[2 * 66] | ((unsigned)s[3 * 66] << 16);
                o.z = (unsigned)s[4 * 66] | ((unsigned)s[5 * 66] << 16); o.w = (unsigned)s[6 * 66] | ((unsigned)s[7 * 66] << 16);
                *(u32x4*)(tdst + (size_t)chh * 128 + jc * 8) = o;
            }
        }
    }
#undef CONV_LOAD
    __syncthreads();
    for (int i = bid_opaque() * NT + tid; i < NTOK * 64; i += G * NT) {
        const float v = DTRAW[i] + dtb[i & 63];
        DT[i] = v > 20.f ? v : log1pf(__expf(v));
    }
}

__device__ __forceinline__ void phase_ssd(const bf16_t* __restrict__ XT, const bf16_t* __restrict__ BM, const bf16_t* __restrict__ BT, const bf16_t* __restrict__ CM, const float* __restrict__ DT,
                          const float* __restrict__ a_log, const float* __restrict__ state_in, int j, bf16_t* __restrict__ YF, bf16_t* __restrict__ YB, float* __restrict__ out_state, unsigned char* smem) {
    constexpr int LS = 136;
    bf16_t* Cs = (bf16_t*)smem;
    bf16_t* Bs = Cs + 128 * LS;
    bf16_t* BTs = Bs + 128 * LS;
    bf16_t* XTs = BTs + 128 * LS;
    bf16_t* Hs = XTs + 64 * LS;
    float* cum = (float*)(Hs + 64 * LS);
    float* dts = cum + 128;
    float* wj = dts + 128;
    float* misc = wj + 128;
    const int tid = tid_opaque(), wid = __builtin_amdgcn_readfirstlane(tid >> 6), lane = tid & 63, fr = lane & 15, fq = lane >> 4;
    const int G = gridDim.x;
    const int strip = wid < 4 ? wid : 11 - wid;
    const int pt = wid & 3, nt0 = (wid >> 2) * 4;
    const int lr = tid >> 4, lc = (tid & 15) * 8;
    const int irow = strip * 16 + fr;
    for (int w = bid_opaque(); w < 256; w += G) {
        const bool samp = w < 128;
#define SSD_DECODE(step_, seq_, dir_, head_, t0_, first_, last_) { \
            if (samp) { seq_ = w >> 6; dir_ = (w >> 5) & 1; head_ = w & 31; const int c_ = dir_ ? 15 - (step_) : (step_); t0_ = 4096 + seq_ * 2048 + c_ * 128; first_ = (step_) == 0; last_ = (step_) == 15; } \
            else { const int pu_ = (w - 128) * 8 + ((step_) >> 1); seq_ = pu_ >> 6; dir_ = (pu_ >> 5) & 1; head_ = pu_ & 31; const int cc_ = (step_) & 1, c_ = dir_ ? 1 - cc_ : cc_; t0_ = seq_ * 256 + c_ * 128; first_ = cc_ == 0; last_ = cc_ == 1; } }
        u32x4 rC[4], rB[4], rBT[4], rX[2]; float rd0 = 0.f, rd1 = 0.f;
#define SSD_ISSUE(step_) { int seq_n, dir_n, head_n, t0_n; bool f_n, l_n; SSD_DECODE(step_, seq_n, dir_n, head_n, t0_n, f_n, l_n); (void)f_n; (void)l_n; (void)seq_n; \
            const int grp_n = head_n >> 3, chunk_n = t0_n >> 7; \
            if (wid == 0) { rd0 = DT[(size_t)(t0_n + lane) * 64 + dir_n * 32 + head_n]; rd1 = DT[(size_t)(t0_n + 64 + lane) * 64 + dir_n * 32 + head_n]; } \
            _Pragma("unroll") for (int i = 0; i < 4; ++i) { const int r = lr + 32 * i; \
                rC[i] = *(const u32x4*)(CM + (size_t)(t0_n + r) * 512 + grp_n * 128 + lc); \
                rB[i] = *(const u32x4*)(BM + (size_t)(t0_n + r) * 512 + grp_n * 128 + lc); \
                rBT[i] = *(const u32x4*)(BT + ((size_t)chunk_n * 512 + grp_n * 128 + r) * 128 + lc); } \
            _Pragma("unroll") for (int i = 0; i < 2; ++i) { const int r = lr + 32 * i; rX[i] = *(const u32x4*)(XT + ((size_t)chunk_n * 2048 + head_n * 64 + r) * 128 + lc); } }
        SSD_ISSUE(0);
        f32x4 hacc[4];
#pragma unroll
        for (int k = 0; k < 4; ++k) hacc[k] = (f32x4){0.f, 0.f, 0.f, 0.f};
        for (int step = 0; step < 16; ++step) {
            int seq, dir, head, t0; bool first, last;
            SSD_DECODE(step, seq, dir, head, t0, first, last);
            const float A2 = -__expf(a_log[dir * 32 + head]) * 1.44269504f;
            bf16_t* Y = dir ? YB : YF;
            const size_t sbase = ((((size_t)(seq * 2 + j) * 2 + dir) * 32 + head) * 64 + pt * 16 + fr) * 128 + fq * 4;
            if (first) {
#pragma unroll
                for (int k = 0; k < 4; ++k) hacc[k] = samp ? *(const f32x4*)(state_in + sbase + (nt0 + k) * 16) : (f32x4){0.f, 0.f, 0.f, 0.f};
            }
#pragma unroll
            for (int k = 0; k < 4; ++k) *(u32x2*)(Hs + (pt * 16 + fr) * LS + (nt0 + k) * 16 + fq * 4) = pack4(hacc[k]);
#pragma unroll
            for (int i = 0; i < 4; ++i) {
                const int r = lr + 32 * i;
                *(u32x4*)(Cs + r * LS + lc) = rC[i]; *(u32x4*)(Bs + r * LS + lc) = rB[i]; *(u32x4*)(BTs + r * LS + lc) = rBT[i];
            }
#pragma unroll
            for (int i = 0; i < 2; ++i) *(u32x4*)(XTs + (lr + 32 * i) * LS + lc) = rX[i];
            if (wid == 0) {
                const float d0 = rd0, d1 = rd1;
                const float v0 = d0 * A2, v1 = d1 * A2;
                float p0 = v0, p1 = v1;
#pragma unroll
                for (int o = 1; o < 64; o <<= 1) { const float a = __shfl_up(p0, o), bq = __shfl_up(p1, o); if (lane >= o) { p0 += a; p1 += bq; } }
                p1 += __shfl(p0, 63);
                const float total = __shfl(p1, 63);
                const float c0 = dir ? total - p0 + v0 : p0, c1 = dir ? total - p1 + v1 : p1;
                cum[lane] = c0; cum[64 + lane] = c1; dts[lane] = d0; dts[64 + lane] = d1;
                wj[lane] = d0 * __builtin_amdgcn_exp2f(total - c0); wj[64 + lane] = d1 * __builtin_amdgcn_exp2f(total - c1);
                if (lane == 0) misc[0] = total;
            }
            __syncthreads();
            if (step + 1 < 16) SSD_ISSUE(step + 1);
            const float ci = cum[irow];
            bf16x8 cf[4];
#pragma unroll
            for (int ns = 0; ns < 4; ++ns) cf[ns] = *(const bf16x8*)(Cs + irow * LS + ns * 32 + fq * 8);
            f32x4 yo[4];
#pragma unroll
            for (int i = 0; i < 4; ++i) yo[i] = (f32x4){0.f, 0.f, 0.f, 0.f};
#pragma unroll
            for (int ns = 0; ns < 4; ++ns)
#pragma unroll
                for (int pp = 0; pp < 4; ++pp) {
                    const bf16x8 a = *(const bf16x8*)(Hs + (pp * 16 + fr) * LS + ns * 32 + fq * 8);
                    yo[pp] = mfma16(a, cf[ns], yo[pp]);
                }
            {
                const float e = __builtin_amdgcn_exp2f(ci);
#pragma unroll
                for (int i = 0; i < 4; ++i) yo[i] *= e;
            }
#pragma unroll
            for (int js = 0; js < 4; ++js) {
                const bool need0 = dir ? (2 * js >= strip) : (2 * js <= strip), need1 = dir ? (2 * js + 1 >= strip) : (2 * js + 1 <= strip);
                if (need0 || need1) {
                    f32x4 g2[2];
#pragma unroll
                    for (int h = 0; h < 2; ++h) {
                        const int jt = js * 2 + h;
                        f32x4 g = {0.f, 0.f, 0.f, 0.f};
                        if (h == 0 ? need0 : need1) {
#pragma unroll
                            for (int ns = 0; ns < 4; ++ns) {
                                const bf16x8 a = *(const bf16x8*)(Bs + (jt * 16 + fr) * LS + ns * 32 + fq * 8);
                                g = mfma16(a, cf[ns], g);
                            }
                            const f32x4 cj = *(const f32x4*)(cum + jt * 16 + fq * 4), dj = *(const f32x4*)(dts + jt * 16 + fq * 4);
                            if (jt == strip) {
#pragma unroll
                                for (int e = 0; e < 4; ++e) {
                                    const int jj = jt * 16 + fq * 4 + e;
                                    const bool ok = dir ? (jj >= irow) : (jj <= irow);
                                    g[e] = ok ? g[e] * __builtin_amdgcn_exp2f(fminf(ci - cj[e], 0.f)) * dj[e] : 0.f;
                                }
                            } else {
#pragma unroll
                                for (int e = 0; e < 4; ++e) g[e] = g[e] * __builtin_amdgcn_exp2f(fminf(ci - cj[e], 0.f)) * dj[e];
                            }
                        }
                        g2[h] = g;
                    }
                    union { u32x4 u; bf16x8 v; } mb;
                    mb.u.x = pk2(g2[0][0], g2[0][1]); mb.u.y = pk2(g2[0][2], g2[0][3]);
                    mb.u.z = pk2(g2[1][0], g2[1][1]); mb.u.w = pk2(g2[1][2], g2[1][3]);
#pragma unroll
                    for (int pp = 0; pp < 4; ++pp) {
                        const bf16_t* xp = XTs + (pp * 16 + fr) * LS + js * 32 + fq * 4;
                        union { u32x4 u; bf16x8 v; } va;
                        const u32x2 lo = *(const u32x2*)xp, hi = *(const u32x2*)(xp + 16);
                        va.u.x = lo.x; va.u.y = lo.y; va.u.z = hi.x; va.u.w = hi.y;
                        yo[pp] = mfma16(va.v, mb.v, yo[pp]);
                    }
                }
            }
#pragma unroll
            for (int pp = 0; pp < 4; ++pp) *(u32x2*)(Y + (size_t)(t0 + irow) * 2048 + head * 64 + pp * 16 + fq * 4) = pack4(yo[pp]);
            {
                const float dec = __builtin_amdgcn_exp2f(misc[0]);
#pragma unroll
                for (int k = 0; k < 4; ++k) hacc[k] *= dec;
#pragma unroll
                for (int js = 0; js < 4; ++js) {
                    const u32x4 xr = *(const u32x4*)(XTs + (pt * 16 + fr) * LS + js * 32 + fq * 8);
                    const f32x4 w0 = *(const f32x4*)(wj + js * 32 + fq * 8), w1 = *(const f32x4*)(wj + js * 32 + fq * 8 + 4);
                    union { u32x4 u; bf16x8 v; } xb;
                    xb.u.x = pk2(bflo(xr.x) * w0[0], bfhi(xr.x) * w0[1]); xb.u.y = pk2(bflo(xr.y) * w0[2], bfhi(xr.y) * w0[3]);
                    xb.u.z = pk2(bflo(xr.z) * w1[0], bfhi(xr.z) * w1[1]); xb.u.w = pk2(bflo(xr.w) * w1[2], bfhi(xr.w) * w1[3]);
#pragma unroll
                    for (int k = 0; k < 4; ++k) {
                        const bf16x8 a = *(const bf16x8*)(BTs + ((nt0 + k) * 16 + fr) * LS + js * 32 + fq * 8);
                        hacc[k] = mfma16(a, xb.v, hacc[k]);
                    }
                }
            }
            __syncthreads();
            if (last && !samp) {
#pragma unroll
                for (int k = 0; k < 4; ++k) *(f32x4*)(out_state + sbase + (nt0 + k) * 16) = hacc[k];
            }
        }
#undef SSD_DECODE
#undef SSD_ISSUE
    }
}

__device__ __forceinline__ void phase_gnorm(const bf16_t* __restrict__ YF, const bf16_t* __restrict__ YB, const bf16_t* __restrict__ XS, const bf16_t* __restrict__ ZXB, const float* __restrict__ dsk,
                            const float* __restrict__ ng, bf16_t* __restrict__ YN) {
    const int tid_ = tid_opaque(); const int lane = tid_ & 63, gw = bid_opaque() * 8 + (tid_ >> 6), nW = gridDim.x * 8;
#pragma unroll 2
    for (int tok = gw; tok < NTOK; tok += nW) {
        float v[4][8]; float ss = 0.f;
#pragma unroll
        for (int jj = 0; jj < 4; ++jj) {
            const int c = jj * 512 + lane * 8, head = c >> 6;
            const float ds = dsk[head] + dsk[32 + head];
            const u32x4 yf = *(const u32x4*)(YF + (size_t)tok * 2048 + c), yb = *(const u32x4*)(YB + (size_t)tok * 2048 + c);
            const u32x4 xs = *(const u32x4*)(XS + (size_t)tok * 2048 + c), z = *(const u32x4*)(ZXB + (size_t)tok * 5120 + c);
#pragma unroll
            for (int q = 0; q < 4; ++q) {
                const float y0 = bflo(yf[q]) + bflo(yb[q]) + ds * bflo(xs[q]), y1 = bfhi(yf[q]) + bfhi(yb[q]) + ds * bfhi(xs[q]);
                const float g0 = y0 * silu_f(bflo(z[q])), g1 = y1 * silu_f(bfhi(z[q]));
                v[jj][2 * q] = g0; v[jj][2 * q + 1] = g1; ss += g0 * g0 + g1 * g1;
            }
        }
        const float r = rsqrtf(wave_sum(ss) * (1.f / 2048) + EPS);
#pragma unroll
        for (int jj = 0; jj < 4; ++jj) {
            const int c = jj * 512 + lane * 8;
            const f32x4 g0 = *(const f32x4*)(ng + c), g1 = *(const f32x4*)(ng + c + 4);
            u32x4 o;
            o.x = pk2(v[jj][0] * r * g0[0], v[jj][1] * r * g0[1]); o.y = pk2(v[jj][2] * r * g0[2], v[jj][3] * r * g0[3]);
            o.z = pk2(v[jj][4] * r * g1[0], v[jj][5] * r * g1[1]); o.w = pk2(v[jj][6] * r * g1[2], v[jj][7] * r * g1[3]);
            *(u32x4*)(YN + (size_t)tok * 2048 + c) = o;
        }
    }
}

#ifndef PHASE_MASK
#define PHASE_MASK 0xFFFF
#endif
#define EN(x) (((PHASE_MASK) >> (x)) & 1)
constexpr int N_PHASES = 50;

__device__ __forceinline__ void run_phase(const Params& p, int ph, unsigned char* smem) {
    size_t zoff = 0; asm volatile("" : "+s"(zoff));
    unsigned char* ws = p.ws + zoff;
    float* X = (float*)(ws + WS_X);
    bf16_t* H = (bf16_t*)(ws + WS_H);
    bf16_t* U = (bf16_t*)(ws + WS_U);
    if (ph == 0) { if (EN(0)) phase0(p, smem); return; }
    if (ph == N_PHASES - 1) { if (EN(2)) phase_final(X, p.in[25], p.out + OUT_Y); return; }
    const int layer = (ph - 1) / 12, s = (ph - 1) % 12, j = layer >> 1;
    const bool is_mla = (layer & 1) == 0;
    const float* modl = (const float*)(ws + WS_MOD) + (size_t)layer * 3 * NMODC;
    if (s == 0 || s == 3 || s == 9) {
        const int ni = s == 0 ? 0 : (s == 3 ? 1 : 2);
        if (EN(1)) phase_norm(X, p.in[8] + (size_t)(layer * 3 + ni) * D, modl, ni * 3, ni * 3 + 1, H);
        return;
    }
    if (s == 1 || s == 10) {
        const int f = s == 1 ? 0 : 1;
        Epi8SwiGLU e{U};
        pg8::StaticOrder so; so.init(NTOK, 5632, gridDim.x, bid_opaque());
        if (EN(3)) pg8::gemm_phase((PG8_LAS unsigned char*)smem, H, (const bf16_t*)(ws + WS_W1T) + (size_t)(layer * 2 + f) * 5632 * 1024, 1024, so, e);
        return;
    }
    if (s == 2 || s == 11 || s == 8) {
        const bf16_t* A; const bf16_t* Bt; int K; int chunk; float sc;
        if (s == 2 || s == 11) { const int f = s == 2 ? 0 : 1; A = U; K = DFF; Bt = (const bf16_t*)(ws + WS_W2T) + (size_t)(layer * 2 + f) * 1024 * 2816; chunk = s == 2 ? 2 : 8; sc = 0.5f; }
        else if (is_mla) { A = (const bf16_t*)(ws + WS_O); K = 1024; Bt = (const bf16_t*)(ws + WS_MWO) + (size_t)j * 1024 * 1024; chunk = 5; sc = 1.f; }
        else { A = (const bf16_t*)(ws + WS_YN); K = 2048; Bt = (const bf16_t*)(ws + WS_SWOUT) + (size_t)j * 1024 * 2048; chunk = 5; sc = 1.f; }
        EpiResid e{X, modl + chunk * 1024, sc};
        if (EN(4)) gemm_tiles(A, K, Bt, K, NTOK, 1024, K, e, smem, 0);
        return;
    }
    if (is_mla) {
        if (s == 4) {
            EpiF32 e{(float*)(ws + WS_QKVA), 800, 800};
            if (EN(5)) gemm_tiles(H, D, (const bf16_t*)(ws + WS_MWIN) + (size_t)j * MLA_NPAD * 1024, 1024, NTOK, MLA_NPAD, 1024, e, smem, 0);
        } else if (s == 5) {
            if (EN(6)) phase_mlanorm((const float*)(ws + WS_QKVA), p.in[12] + j * 512, p.in[13] + j * 256, p.in[2], j, (const float*)(ws + WS_ROPE),
                          (bf16_t*)(ws + WS_QA), (bf16_t*)(ws + WS_CKV), (bf16_t*)(ws + WS_KR), p.out + OUT_CACHE);
        } else if (s == 6) {
            EpiQ eq{(bf16_t*)(ws + WS_Q), (const float*)(ws + WS_ROPE), 0.14724444f  };
            if (EN(7)) gemm_tiles((const bf16_t*)(ws + WS_QA), 512, (const bf16_t*)(ws + WS_MWQB) + (size_t)j * 1536 * 512, 512, NTOK, 1536, 512, eq, smem, 0);
            {
                EpiBf16 e{(bf16_t*)(ws + WS_KN), 1024};
                if (EN(7)) gemm_tiles((const bf16_t*)(ws + WS_CKV), 256, (const bf16_t*)(ws + WS_MWKN) + (size_t)j * 1024 * 256, 256, NTOKKV, 1024, 256, e, smem, 128);
            }
            {
                EpiBf16T e{(bf16_t*)(ws + WS_VT), NTOKKV};
                if (EN(7)) gemm_tiles((const bf16_t*)(ws + WS_MWV) + (size_t)j * 1024 * 256, 256, (const bf16_t*)(ws + WS_CKV), 256, 1024, NTOKKV, 256, e, smem, 144);
            }
        } else if (s == 7) {
            if (EN(8)) phase_attn((const bf16_t*)(ws + WS_Q), (const bf16_t*)(ws + WS_KN), (const bf16_t*)(ws + WS_KR), (const bf16_t*)(ws + WS_VT), (bf16_t*)(ws + WS_O), smem);
        }
    } else {
        if (s == 4) {
            Epi8SSMIn e{(bf16_t*)(ws + WS_ZXB), (float*)(ws + WS_DTRAW)};
            pg8::StaticOrder so; so.init(NTOK, SSM_NPAD, gridDim.x, bid_opaque());
            if (EN(9)) pg8::gemm_phase((PG8_LAS unsigned char*)smem, H, (const bf16_t*)(ws + WS_SWIN) + (size_t)j * SSM_NPAD * 1024, 1024, so, e);
        } else if (s == 5) {
            if (EN(10)) phase_conv((const bf16_t*)(ws + WS_ZXB), (const float*)(ws + WS_DTRAW), p.in[18] + (size_t)j * 5 * 3072, p.in[19] + j * 3072, p.in[20] + j * 64,
                       (bf16_t*)(ws + WS_XS), (bf16_t*)(ws + WS_XT), (bf16_t*)(ws + WS_BM), (bf16_t*)(ws + WS_BT), (bf16_t*)(ws + WS_CM), (float*)(ws + WS_DT), smem);
        } else if (s == 6) {
            if (EN(11)) phase_ssd((const bf16_t*)(ws + WS_XT), (const bf16_t*)(ws + WS_BM), (const bf16_t*)(ws + WS_BT), (const bf16_t*)(ws + WS_CM), (const float*)(ws + WS_DT),
                      p.in[21] + j * 64, p.in[3], j, (bf16_t*)(ws + WS_YF), (bf16_t*)(ws + WS_YB), p.out + OUT_STATE, smem);
        } else if (s == 7) {
            if (EN(12)) phase_gnorm((const bf16_t*)(ws + WS_YF), (const bf16_t*)(ws + WS_YB), (const bf16_t*)(ws + WS_XS), (const bf16_t*)(ws + WS_ZXB), p.in[22] + j * 64, p.in[23] + j * 2048,
                        (bf16_t*)(ws + WS_YN));
        }
    }
}

#define XB_TMO      128
#define XB_XCNT(j)  (256  + 64 * (j))
#define XB_XSUB(j)  (1280 + 64 * (j))
#define XB_XGEN(j)  (2304 + 64 * (j))
#define XB_TOP      3328
#define XB_TOPGEN   3392
#define XCD_BAR_WORDS 3456
#define XB_SPIN_CAP (1u << 18)
#define LAS __attribute__((address_space(3)))

__device__ __forceinline__ unsigned xb_ld(unsigned* p)              { return __hip_atomic_load(p, __ATOMIC_RELAXED, __HIP_MEMORY_SCOPE_AGENT); }
__device__ __forceinline__ unsigned xb_add(unsigned* p, unsigned v) { return __hip_atomic_fetch_add(p, v, __ATOMIC_RELAXED, __HIP_MEMORY_SCOPE_AGENT); }
__device__ __forceinline__ unsigned xb_xcc_id() { return (unsigned)__builtin_amdgcn_s_getreg((3 << 11) | 20) & 0xFu; }
#define XB_SPIN(cond, bar) do { unsigned _sp = 0; while (cond) { __builtin_amdgcn_s_sleep(1); \
    if ((++_sp & 255u) == 0u) { if (xb_ld(&(bar)[XB_TMO])) break; if (_sp > XB_SPIN_CAP) { atomicAdd(&(bar)[XB_TMO], 1u); break; } } } } while (0)

struct XcdBarrier {
    unsigned* bar; unsigned x;
    volatile LAS unsigned* st;
};

__device__ __forceinline__ XcdBarrier xcd_barrier_post(unsigned* bar, volatile LAS unsigned* st) {
    XcdBarrier b; b.bar = bar; b.x = xb_xcc_id(); b.st = st;
    if (threadIdx.x == 0) (void)xb_add(&bar[XB_XCNT(b.x)], 1u);
    return b;
}
__device__ __forceinline__ void xcd_barrier_complete(unsigned* bar, unsigned x, unsigned& nloc, unsigned& nx) {
    const unsigned G = gridDim.x * gridDim.y * gridDim.z;
    unsigned sum, cnt, mine, sp = 0u;
    for (;;) {
        sum = 0u; cnt = 0u; mine = 0u;
#pragma unroll
        for (unsigned j = 0; j < 16; ++j) { const unsigned c = xb_ld(&bar[XB_XCNT(j)]); sum += c; cnt += (c > 0u) ? 1u : 0u; mine = (j == x) ? c : mine; }
        if (sum == G) break;
        __builtin_amdgcn_s_sleep(1);
        if ((++sp & 255u) == 0u) { if (xb_ld(&bar[XB_TMO])) break; if (sp > XB_SPIN_CAP) { atomicAdd(&bar[XB_TMO], 1u); break; } }
    }
    nloc = mine > 0u ? mine : 1u; nx = cnt > 0u ? cnt : 1u;
}

__device__ __forceinline__ void xcd_barrier(const XcdBarrier& b) {
    asm volatile("s_waitcnt vmcnt(0)" ::: "memory");
    __syncthreads();
    if (threadIdx.x == 0) {
        unsigned* bar = b.bar;
        __builtin_amdgcn_s_waitcnt(0);
        unsigned nloc = b.st[0], nx = b.st[1];
        if (nloc == 0u) { xcd_barrier_complete(bar, b.x, nloc, nx); b.st[0] = nloc; b.st[1] = nx; }
        const unsigned old = xb_add(&bar[XB_XSUB(b.x)], 1u);
        const unsigned gen = old / nloc;
        if (old + 1u == (gen + 1u) * nloc) {
            __builtin_amdgcn_fence(__ATOMIC_RELEASE, "agent");
            asm volatile("s_waitcnt vmcnt(0)" ::: "memory");
            const unsigned og = xb_add(&bar[XB_TOP], 1u);
            const unsigned tg = og / nx;
            if (og + 1u == (tg + 1u) * nx) xb_add(&bar[XB_TOPGEN], 1u);
            else XB_SPIN(xb_ld(&bar[XB_TOPGEN]) == tg, bar);
            __builtin_amdgcn_fence(__ATOMIC_ACQUIRE, "agent");
            xb_add(&bar[XB_XGEN(b.x)], 1u);
            asm volatile("s_waitcnt vmcnt(0)" ::: "memory");
        } else {
            XB_SPIN(xb_ld(&bar[XB_XGEN(b.x)]) == gen, bar);
            __builtin_amdgcn_fence(__ATOMIC_ACQUIRE, "agent");
            asm volatile("s_waitcnt vmcnt(0)" ::: "memory");
        }
    }
    __syncthreads();
}

__device__ __forceinline__ void grid_barrier(unsigned* ctr, unsigned target) {
    __syncthreads();
    if (threadIdx.x == 0) {
        __threadfence();
        __hip_atomic_fetch_add(ctr, 1u, __ATOMIC_RELAXED, __HIP_MEMORY_SCOPE_AGENT);
        while (__hip_atomic_load(ctr, __ATOMIC_RELAXED, __HIP_MEMORY_SCOPE_AGENT) < target) __builtin_amdgcn_s_sleep(1);
        __threadfence();
    }
    __syncthreads();
}

__global__ void __launch_bounds__(NT) mega_fwd(Params p) {
    extern __shared__ __attribute__((aligned(16))) unsigned char smem[];
    cg::grid_group grid = cg::this_grid();
    volatile LAS unsigned* xst = (volatile LAS unsigned*)(smem + LDS_BYTES - 16);
    if (threadIdx.x == 0) { xst[0] = 0u; xst[1] = 0u; }
    __syncthreads();
    XcdBarrier xb = xcd_barrier_post((unsigned*)(p.ws + WS_BAR), xst);
    for (int ph = p.ph_lo; ph < p.ph_hi; ++ph) {
        if (ph > p.ph_lo) { if (ph == 1) grid.sync(); else xcd_barrier(xb); }
        run_phase(p, ph, smem);
    }
}

extern "C" void kernel_launch(void* const* d_in, const int* in_sizes, int n_in, void* d_out, int out_size, void* d_ws, size_t ws_size, hipStream_t stream) {
    static int grid_blocks = 0;
    if (grid_blocks == 0) {
        if (n_in != 26 || ws_size < WS_END) { fprintf(stderr, "kernel_launch: unexpected n_in %d / ws_size %zu (need %zu)\n", n_in, ws_size, (size_t)WS_END); grid_blocks = -1; return; }
        int dev = 0, cus = 0, per_cu = 0;
        (void)hipGetDevice(&dev);
        (void)hipDeviceGetAttribute(&cus, hipDeviceAttributeMultiprocessorCount, dev);
        if (hipFuncSetAttribute((const void*)mega_fwd, hipFuncAttributeMaxDynamicSharedMemorySize, LDS_BYTES) != hipSuccess) { fprintf(stderr, "kernel_launch: hipFuncSetAttribute failed\n"); }
        if (hipOccupancyMaxActiveBlocksPerMultiprocessor(&per_cu, (const void*)mega_fwd, NT, LDS_BYTES) != hipSuccess || per_cu < 1) { fprintf(stderr, "kernel_launch: occupancy query says %d\n", per_cu); per_cu = 1; }
        (void)hipGetLastError();
        grid_blocks = cus * 1;
        if (grid_blocks <= 0) grid_blocks = 256;
    }
    if (grid_blocks < 0) return;
    Params p;
    memset(&p, 0, sizeof(p));
    for (int i = 0; i < 26; ++i) p.in[i] = (const float*)d_in[i];
    p.out = (float*)d_out; p.ws = (unsigned char*)d_ws;
#if N_LAUNCH_MODE == 1
    (void)hipMemsetAsync((unsigned char*)d_ws + WS_BAR, 0, 16384, stream);
    p.ph_lo = 0; p.ph_hi = N_PHASES;
    void* args[] = {&p};
    hipError_t e = hipLaunchCooperativeKernel((const void*)mega_fwd, dim3(grid_blocks), dim3(NT), args, LDS_BYTES, stream);
    if (e != hipSuccess) fprintf(stderr, "cooperative launch failed: %s (grid %d)\n", hipGetErrorString(e), grid_blocks);
#else
    for (int ph = 0; ph < N_PHASES; ++ph) {
#ifdef PH_LIMIT
        if (ph >= PH_LIMIT && ph != N_PHASES - 1) continue;
#endif
        p.ph_lo = ph; p.ph_hi = ph + 1;
        hipLaunchKernelGGL(mega_fwd, dim3(grid_blocks), dim3(NT), LDS_BYTES, stream, p);
    }
#endif
}
```

```cpp
#include <hip/hip_runtime.h>
#include <hip/hip_cooperative_groups.h>
#include <cstdio>
#include <cstring>
namespace cg = cooperative_groups;

#ifndef N_LAUNCH_MODE
#define N_LAUNCH_MODE 1
#endif

typedef unsigned short bf16_t;
typedef short bf16x8 __attribute__((ext_vector_type(8)));
typedef float f32x4 __attribute__((ext_vector_type(4)));
typedef unsigned u32x2 __attribute__((ext_vector_type(2)));
typedef unsigned u32x4 __attribute__((ext_vector_type(4)));

constexpr int NT = 512;
constexpr int NTOK = 8192;
constexpr int NTOKKV = 8704;
constexpr int D = 1024, DFF = 2816, NMODC = 9216;
constexpr int SSM_NPAD = 5376;
constexpr int MLA_NPAD = 896;
constexpr float EPS = 1e-6f;

constexpr size_t al256(size_t x) { return (x + 255) & ~(size_t)255; }
constexpr size_t WS_X = 0;
constexpr size_t WS_H = WS_X + al256((size_t)NTOK * D * 4);
constexpr size_t WS_U = WS_H + al256((size_t)NTOK * D * 2);
constexpr size_t WS_MOD = WS_U + al256((size_t)NTOK * DFF * 2);
constexpr size_t WS_ROPE = WS_MOD + al256((size_t)4 * 3 * NMODC * 4);
constexpr size_t WS_W1T = WS_ROPE + al256((size_t)2048 * 32 * 4);
constexpr size_t WS_W2T = WS_W1T + al256((size_t)8 * 5632 * 1024 * 2);
constexpr size_t WS_MWIN = WS_W2T + al256((size_t)8 * 1024 * 2816 * 2);
constexpr size_t WS_MWQB = WS_MWIN + al256((size_t)2 * MLA_NPAD * 1024 * 2);
constexpr size_t WS_MWKN = WS_MWQB + al256((size_t)2 * 1536 * 512 * 2);
constexpr size_t WS_MWV = WS_MWKN + al256((size_t)2 * 1024 * 256 * 2);
constexpr size_t WS_MWO = WS_MWV + al256((size_t)2 * 1024 * 256 * 2);
constexpr size_t WS_SWIN = WS_MWO + al256((size_t)2 * 1024 * 1024 * 2);
constexpr size_t WS_SWOUT = WS_SWIN + al256((size_t)2 * SSM_NPAD * 1024 * 2);
constexpr size_t WS_TMP = WS_SWOUT + al256((size_t)2 * 1024 * 2048 * 2);
constexpr size_t WS_QKVA = WS_TMP;
constexpr size_t WS_QA = WS_QKVA + al256((size_t)NTOK * 800 * 4);
constexpr size_t WS_CKV = WS_QA + al256((size_t)NTOK * 512 * 2);
constexpr size_t WS_KR = WS_CKV + al256((size_t)NTOKKV * 256 * 2);
constexpr size_t WS_Q = WS_KR + al256((size_t)NTOKKV * 32 * 2);
constexpr size_t WS_KN = WS_Q + al256((size_t)NTOK * 1536 * 2);
constexpr size_t WS_VT = WS_KN + al256((size_t)NTOKKV * 1024 * 2);
constexpr size_t WS_O = WS_VT + al256((size_t)1024 * NTOKKV * 2);
constexpr size_t WS_MLA_END = WS_O + al256((size_t)NTOK * 1024 * 2);
constexpr size_t WS_ZXB = WS_TMP;
constexpr size_t WS_DTRAW = WS_ZXB + al256((size_t)NTOK * 5120 * 2);
constexpr size_t WS_XS = WS_DTRAW + al256((size_t)NTOK * 64 * 4);
constexpr size_t WS_XT = WS_XS + al256((size_t)NTOK * 2048 * 2);
constexpr size_t WS_BM = WS_XT + al256((size_t)NTOK * 2048 * 2);
constexpr size_t WS_BT = WS_BM + al256((size_t)NTOK * 512 * 2);
constexpr size_t WS_CM = WS_BT + al256((size_t)NTOK * 512 * 2);
constexpr size_t WS_DT = WS_CM + al256((size_t)NTOK * 512 * 2);
constexpr size_t WS_YF = WS_DT + al256((size_t)NTOK * 64 * 4);
constexpr size_t WS_YB = WS_YF + al256((size_t)NTOK * 2048 * 2);
constexpr size_t WS_YN = WS_YB + al256((size_t)NTOK * 2048 * 2);
constexpr size_t WS_SSM_END = WS_YN + al256((size_t)NTOK * 2048 * 2);
constexpr size_t WS_BAR = WS_SSM_END > WS_MLA_END ? WS_SSM_END : WS_MLA_END;
constexpr size_t WS_END = WS_BAR + 16384;

constexpr size_t OUT_Y = 0;
constexpr size_t OUT_CACHE = (size_t)NTOK * D;
constexpr size_t OUT_STATE = OUT_CACHE + (size_t)16 * 2 * 256 * 288;

constexpr int LDS_BYTES = 141312;

struct Params {
    const float* in[26];
    float* out;
    unsigned char* ws;
    int ph_lo, ph_hi;
};

typedef __bf16 bf16v2_t __attribute__((ext_vector_type(2)));
typedef float f32v2_t __attribute__((ext_vector_type(2)));
__device__ __forceinline__ unsigned pk2(float lo, float hi) { f32v2_t f = {lo, hi}; bf16v2_t b = __builtin_convertvector(f, bf16v2_t); return __builtin_bit_cast(unsigned, b); }
__device__ __forceinline__ bf16_t f2bf(float f) { return (bf16_t)(pk2(f, 0.f) & 0xffffu); }
__device__ __forceinline__ float bflo(unsigned u) { return __uint_as_float(u << 16); }
__device__ __forceinline__ float bfhi(unsigned u) { return __uint_as_float(u & 0xffff0000u); }
__device__ __forceinline__ float silu_f(float x) { return x / (1.f + __expf(-x)); }
__device__ __forceinline__ float wave_sum(float v) {
#pragma unroll
    for (int o = 32; o > 0; o >>= 1) v += __shfl_xor(v, o);
    return v;
}
__device__ __forceinline__ u32x2 pack4(f32x4 v) { u32x2 r; r.x = pk2(v[0], v[1]); r.y = pk2(v[2], v[3]); return r; }
__device__ __forceinline__ f32x4 mfma16(bf16x8 a, bf16x8 b, f32x4 c) { return __builtin_amdgcn_mfma_f32_16x16x32_bf16(a, b, c, 0, 0, 0); }
__device__ __forceinline__ int modrow(int tok) { return tok < 4096 ? 0 : 1 + ((tok - 4096) >> 11); }

__device__ __forceinline__ int tid_opaque() { int t = threadIdx.x; asm volatile("" : "+v"(t)); return t; }
__device__ __forceinline__ int bid_opaque() { int t = blockIdx.x; asm volatile("" : "+s"(t)); return t; }
__device__ __forceinline__ void conv_tile(const float* __restrict__ src, int ldsrc, int nvalid, int mode, bf16_t* __restrict__ dst, int K, int n0, int k0, bf16_t* tile) {
    const int tid = tid_opaque();
    {
        const int nn = tid & 63, kr = tid >> 6, n = n0 + nn;
        int col; bool valid = true;
        if (mode == 0) { col = n; valid = n < nvalid; }
        else if (mode == 1) { const int q = n >> 8, w = n & 255; col = (w < 128) ? (q * 128 + w) : (DFF + q * 128 + (w - 128)); }
        else if (mode == 2) { col = (n >> 6) * 128 + (n & 63); }
        else { col = (n >> 6) * 128 + 64 + (n & 63); }
        const float* s = src + (size_t)(k0 + kr) * ldsrc + col;
#pragma unroll
        for (int ps = 0; ps < 8; ++ps) {
            const float v = valid ? __builtin_nontemporal_load(s + (size_t)(ps * 8) * ldsrc) : 0.f;
            tile[nn * 66 + ps * 8 + kr] = f2bf(v);
        }
    }
    __syncthreads();
    {
        const int nn = tid >> 3, ch = tid & 7;
        const unsigned* t32 = (const unsigned*)tile + nn * 33 + ch * 4;
        u32x4 o; o.x = t32[0]; o.y = t32[1]; o.z = t32[2]; o.w = t32[3];
        *(u32x4*)(dst + (size_t)(n0 + nn) * K + k0 + ch * 8) = o;
    }
    __syncthreads();
}

__device__ __forceinline__ void phase0(const Params& p, unsigned char* smem) {
    const int tid = tid_opaque(), G = gridDim.x, b = bid_opaque();
    float* X = (float*)(p.ws + WS_X);
    {
        const f32x4* xp = (const f32x4*)p.in[0]; const f32x4* xs = (const f32x4*)p.in[1]; f32x4* xo = (f32x4*)X;
        const int n4 = NTOK * D / 4, half = n4 / 2;
        for (int i = b * NT + tid; i < n4; i += G * NT) xo[i] = i < half ? xp[i] : xs[i - half];
    }
    {
        float* rope = (float*)(p.ws + WS_ROPE);
        for (int i = b * NT + tid; i < 2048 * 16; i += G * NT) {
            const int pos = i >> 4, a = (i >> 3) & 1, f = i & 7;
            const double position = a == 0 ? (double)(pos >> 6) : (double)(pos & 63);
            double freq = (f & 1) ? 0.31622776601683794 : 1.0;
            const int f2 = f >> 1; if (f2 == 1) freq *= 0.1; else if (f2 == 2) freq *= 0.01; else if (f2 == 3) freq *= 0.001;
            const double ang = position * freq;
            const double kq = rint(ang * 0.63661977236758134);
            const double r = ang - kq * 1.5707963267948966;
            const double r2 = r * r;
            double sn = r * (1.0 + r2 * (-1.0 / 6 + r2 * (1.0 / 120 + r2 * (-1.0 / 5040 + r2 * (1.0 / 362880 + r2 * (-1.0 / 39916800 + r2 * (1.0 / 6227020800.0 + r2 * (-1.0 / 1307674368000.0))))))));
            double cs = 1.0 + r2 * (-0.5 + r2 * (1.0 / 24 + r2 * (-1.0 / 720 + r2 * (1.0 / 40320 + r2 * (-1.0 / 3628800 + r2 * (1.0 / 479001600.0 + r2 * (-1.0 / 87178291200.0 + r2 * (1.0 / 20922789888000.0))))))));
            const int q = ((int)kq) & 3;
            double c, s;
            if (q == 0) { c = cs; s = sn; } else if (q == 1) { c = -sn; s = cs; } else if (q == 2) { c = -cs; s = -sn; } else { c = sn; s = -cs; }
            rope[pos * 32 + a * 8 + f] = (float)c;
            rope[pos * 32 + 16 + a * 8 + f] = (float)s;
        }
    }
    {
        float* sc = (float*)smem; float* red = sc + 3072;
        const float* cin = p.in[4]; const float* cctx = p.in[5];
        for (int i = tid; i < 3072; i += NT) { const int row = i >> 10, k = i & 1023; const float c = row == 0 ? cctx[k] : cin[(row - 1) * 1024 + k]; sc[i] = silu_f(c); }
        __syncthreads();
        float* MOD = (float*)(p.ws + WS_MOD);
        for (int item = b; item < 4 * 288; item += G) {
            const int layer = item / 288, col0 = (item % 288) * 32;
            const int cq = tid & 7, ks = tid >> 3;
            const float* w = p.in[6] + (size_t)layer * 1024 * NMODC + (size_t)(ks * 16) * NMODC + col0 + cq * 4;
            f32x4 a0 = {0.f, 0.f, 0.f, 0.f}, a1 = a0, a2 = a0;
            f32x4 wv[16];
#pragma unroll
            for (int kk = 0; kk < 16; ++kk) wv[kk] = __builtin_nontemporal_load((const f32x4*)(w + (size_t)kk * NMODC));
            asm volatile("" ::: "memory");
#pragma unroll
            for (int kk = 0; kk < 16; ++kk) {
                const int k = ks * 16 + kk;
                a0 += sc[k] * wv[kk]; a1 += sc[1024 + k] * wv[kk]; a2 += sc[2048 + k] * wv[kk];
            }
            *(f32x4*)(red + ks * 96 + cq * 4) = a0; *(f32x4*)(red + ks * 96 + 32 + cq * 4) = a1; *(f32x4*)(red + ks * 96 + 64 + cq * 4) = a2;
            __syncthreads();
            if (tid < 96) {
                float s = 0.f;
                for (int k2 = 0; k2 < 64; ++k2) s += red[k2 * 96 + tid];
                const int row = tid >> 5, c = tid & 31;
                MOD[(size_t)(layer * 3 + row) * NMODC + col0 + c] = s + p.in[7][(size_t)layer * NMODC + col0 + c];
            }
            __syncthreads();
        }
    }
    {
        bf16_t* tile = (bf16_t*)smem;
        constexpr int T_W1 = 88 * 16, T_W2 = 16 * 44, T_MIN = 14 * 16, T_MQB = 24 * 8, T_MKV = 16 * 4, T_MO = 16 * 16, T_SIN = 84 * 16, T_SOUT = 16 * 32;
        constexpr int TOTAL = 8 * T_W1 + 8 * T_W2 + 2 * (T_MIN + T_MQB + 2 * T_MKV + T_MO) + 2 * (T_SIN + T_SOUT);
        const int nn = tid & 63, kr = tid >> 6, on = tid >> 3, och = tid & 7;
        for (int t0 = b; t0 < TOTAL; t0 += 4 * G) {
            float v[4][8];
            bf16_t* dsts[4];
#pragma unroll
            for (int u = 0; u < 4; ++u) {
                int r = t0 + u * G;
                const bool live = r < TOTAL;
                if (!live) r = 0;
                const float* src; bf16_t* dst; int K, ld, nvalid, mode;
                if (r < 8 * T_W1) { const int j = r / T_W1; r -= j * T_W1; src = p.in[9] + (size_t)j * 1024 * 5632; dst = (bf16_t*)(p.ws + WS_W1T) + (size_t)j * 5632 * 1024; K = 1024; ld = 5632; nvalid = 5632; mode = 1; }
                else if ((r -= 8 * T_W1) < 8 * T_W2) { const int j = r / T_W2; r -= j * T_W2; src = p.in[10] + (size_t)j * 2816 * 1024; dst = (bf16_t*)(p.ws + WS_W2T) + (size_t)j * 1024 * 2816; K = 2816; ld = 1024; nvalid = 1024; mode = 0; }
                else if ((r -= 8 * T_W2) < 2 * T_MIN) { const int j = r / T_MIN; r -= j * T_MIN; src = p.in[11] + (size_t)j * 1024 * 800; dst = (bf16_t*)(p.ws + WS_MWIN) + (size_t)j * MLA_NPAD * 1024; K = 1024; ld = 800; nvalid = 800; mode = 0; }
                else if ((r -= 2 * T_MIN) < 2 * T_MQB) { const int j = r / T_MQB; r -= j * T_MQB; src = p.in[14] + (size_t)j * 512 * 1536; dst = (bf16_t*)(p.ws + WS_MWQB) + (size_t)j * 1536 * 512; K = 512; ld = 1536; nvalid = 1536; mode = 0; }
                else if ((r -= 2 * T_MQB) < 2 * T_MKV) { const int j = r / T_MKV; r -= j * T_MKV; src = p.in[15] + (size_t)j * 256 * 2048; dst = (bf16_t*)(p.ws + WS_MWKN) + (size_t)j * 1024 * 256; K = 256; ld = 2048; nvalid = 1024; mode = 2; }
                else if ((r -= 2 * T_MKV) < 2 * T_MKV) { const int j = r / T_MKV; r -= j * T_MKV; src = p.in[15] + (size_t)j * 256 * 2048; dst = (bf16_t*)(p.ws + WS_MWV) + (size_t)j * 1024 * 256; K = 256; ld = 2048; nvalid = 1024; mode = 3; }
                else if ((r -= 2 * T_MKV) < 2 * T_MO) { const int j = r / T_MO; r -= j * T_MO; src = p.in[16] + (size_t)j * 1024 * 1024; dst = (bf16_t*)(p.ws + WS_MWO) + (size_t)j * 1024 * 1024; K = 1024; ld = 1024; nvalid = 1024; mode = 0; }
                else if ((r -= 2 * T_MO) < 2 * T_SIN) { const int j = r / T_SIN; r -= j * T_SIN; src = p.in[17] + (size_t)j * 1024 * 5184; dst = (bf16_t*)(p.ws + WS_SWIN) + (size_t)j * SSM_NPAD * 1024; K = 1024; ld = 5184; nvalid = 5184; mode = 0; }
                else { r -= 2 * T_SIN; const int j = r / T_SOUT; r -= j * T_SOUT; src = p.in[24] + (size_t)j * 2048 * 1024; dst = (bf16_t*)(p.ws + WS_SWOUT) + (size_t)j * 1024 * 2048; K = 2048; ld = 1024; nvalid = 1024; mode = 0; }
                const int nkt = K >> 6, n0 = (r / nkt) * 64, k0 = (r % nkt) * 64, n = n0 + nn;
                int col; bool valid = live;
                if (mode == 0) { col = n; valid = valid && n < nvalid; }
                else if (mode == 1) { const int q = n >> 8, w = n & 255; col = (w < 128) ? (q * 128 + w) : (DFF + q * 128 + (w - 128)); }
                else if (mode == 2) { col = (n >> 6) * 128 + (n & 63); }
                else { col = (n >> 6) * 128 + 64 + (n & 63); }
                const float* sp = src + (size_t)(k0 + kr) * ld + (valid ? col : 0);
#pragma unroll
                for (int ps = 0; ps < 8; ++ps) { const float x = __builtin_nontemporal_load(sp + (size_t)(ps * 8) * ld); v[u][ps] = valid ? x : 0.f; }
                dsts[u] = live ? dst + (size_t)(n0 + on) * K + k0 + och * 8 : nullptr;
            }
#pragma unroll
            for (int u = 0; u < 4; ++u)
#pragma unroll
                for (int ps = 0; ps < 8; ++ps) tile[u * 4224 + nn * 66 + ps * 8 + kr] = f2bf(v[u][ps]);
            __syncthreads();
#pragma unroll
            for (int u = 0; u < 4; ++u) {
                const unsigned* t32 = (const unsigned*)(tile + u * 4224) + on * 33 + och * 4;
                u32x4 o; o.x = t32[0]; o.y = t32[1]; o.z = t32[2]; o.w = t32[3];
                if (dsts[u]) *(u32x4*)dsts[u] = o;
            }
            __syncthreads();
        }
    }
}

__device__ __forceinline__ void phase_norm(const float* __restrict__ X, const float* __restrict__ g, const float* __restrict__ modl, int shift_chunk, int scale_chunk, bf16_t* __restrict__ H) {
    const int tid_ = tid_opaque(); const int lane = tid_ & 63, gw = bid_opaque() * 8 + (tid_ >> 6), nW = gridDim.x * 8;
#pragma unroll 4
    for (int tok = gw; tok < NTOK; tok += nW) {
        const float* xr = X + (size_t)tok * D + lane * 4;
        f32x4 v[4]; float ss = 0.f;
#pragma unroll
        for (int j = 0; j < 4; ++j) { v[j] = *(const f32x4*)(xr + 256 * j); ss += v[j][0] * v[j][0] + v[j][1] * v[j][1] + v[j][2] * v[j][2] + v[j][3] * v[j][3]; }
        const float r = rsqrtf(wave_sum(ss) * (1.f / D) + EPS);
        const float* mr = modl + (size_t)modrow(tok) * NMODC;
#pragma unroll
        for (int j = 0; j < 4; ++j) {
            const int k = lane * 4 + 256 * j;
            const f32x4 gv = *(const f32x4*)(g + k), sc = *(const f32x4*)(mr + scale_chunk * 1024 + k), sh = *(const f32x4*)(mr + shift_chunk * 1024 + k);
            f32x4 h;
#pragma unroll
            for (int e = 0; e < 4; ++e) h[e] = v[j][e] * r * gv[e] * (1.f + sc[e]) + sh[e];
            *(u32x2*)(H + (size_t)tok * D + k) = pack4(h);
        }
    }
}
__device__ __forceinline__ void phase_final(const float* __restrict__ X, const float* __restrict__ g, float* __restrict__ out) {
    const int tid_ = tid_opaque(); const int lane = tid_ & 63, gw = bid_opaque() * 8 + (tid_ >> 6), nW = gridDim.x * 8;
#pragma unroll 4
    for (int tok = gw; tok < NTOK; tok += nW) {
        const float* xr = X + (size_t)tok * D + lane * 4;
        f32x4 v[4]; float ss = 0.f;
#pragma unroll
        for (int j = 0; j < 4; ++j) { v[j] = *(const f32x4*)(xr + 256 * j); ss += v[j][0] * v[j][0] + v[j][1] * v[j][1] + v[j][2] * v[j][2] + v[j][3] * v[j][3]; }
        const float r = rsqrtf(wave_sum(ss) * (1.f / D) + EPS);
#pragma unroll
        for (int j = 0; j < 4; ++j) {
            const int k = lane * 4 + 256 * j;
            const f32x4 gv = *(const f32x4*)(g + k);
            f32x4 h;
#pragma unroll
            for (int e = 0; e < 4; ++e) h[e] = v[j][e] * r * gv[e];
            *(f32x4*)(out + (size_t)tok * D + k) = h;
        }
    }
}

struct EpiSwiGLU {
    bf16_t* U;
    __device__ __forceinline__ void operator()(f32x4 (&acc)[4][4], int row0, int col0, int fr, int fq) const {
        const int j0 = (col0 >> 6) * 32;
#pragma unroll
        for (int mt = 0; mt < 4; ++mt) {
            const int row = row0 + mt * 16 + fr;
#pragma unroll
            for (int h = 0; h < 2; ++h) {
                f32x4 o;
#pragma unroll
                for (int e = 0; e < 4; ++e) o[e] = silu_f(acc[mt][h][e]) * acc[mt][h + 2][e];
                *(u32x2*)(U + (size_t)row * DFF + j0 + h * 16 + fq * 4) = pack4(o);
            }
        }
    }
};
struct EpiResid {
    float* X; const float* gate; float s;
    __device__ __forceinline__ void operator()(f32x4 (&acc)[4][4], int row0, int col0, int fr, int fq) const {
        const float* gr = gate + (size_t)modrow(row0) * NMODC + col0 + fq * 4;
        float* xp0 = X + (size_t)(row0 + fr) * D + col0 + fq * 4;
        f32x4 gv[4], x[4][4];
#pragma unroll
        for (int nt = 0; nt < 4; ++nt) gv[nt] = *(const f32x4*)(gr + nt * 16);
#pragma unroll
        for (int mt = 0; mt < 4; ++mt)
#pragma unroll
            for (int nt = 0; nt < 4; ++nt) x[mt][nt] = *(const f32x4*)(xp0 + (size_t)(mt * 16) * D + nt * 16);
        asm volatile("" ::: "memory");
#pragma unroll
        for (int mt = 0; mt < 4; ++mt)
#pragma unroll
            for (int nt = 0; nt < 4; ++nt) {
#pragma unroll
                for (int e = 0; e < 4; ++e) x[mt][nt][e] += s * gv[nt][e] * acc[mt][nt][e];
                *(f32x4*)(xp0 + (size_t)(mt * 16) * D + nt * 16) = x[mt][nt];
            }
    }
};
struct EpiF32 {
    float* C; int ldc, ncols;
    __device__ __forceinline__ void operator()(f32x4 (&acc)[4][4], int row0, int col0, int fr, int fq) const {
#pragma unroll
        for (int mt = 0; mt < 4; ++mt)
#pragma unroll
            for (int nt = 0; nt < 4; ++nt) {
                const int row = row0 + mt * 16 + fr, col = col0 + nt * 16 + fq * 4;
                if (col < ncols) *(f32x4*)(C + (size_t)row * ldc + col) = acc[mt][nt];
            }
    }
};
struct EpiBf16 {
    bf16_t* C; int ldc;
    __device__ __forceinline__ void operator()(f32x4 (&acc)[4][4], int row0, int col0, int fr, int fq) const {
#pragma unroll
        for (int mt = 0; mt < 4; ++mt)
#pragma unroll
            for (int nt = 0; nt < 4; ++nt) {
                const int row = row0 + mt * 16 + fr, col = col0 + nt * 16 + fq * 4;
                *(u32x2*)(C + (size_t)row * ldc + col) = pack4(acc[mt][nt]);
            }
    }
};
struct EpiBf16T {
    bf16_t* C; int ldc;
    __device__ __forceinline__ void operator()(f32x4 (&acc)[4][4], int row0, int col0, int fr, int fq) const {
#pragma unroll
        for (int mt = 0; mt < 4; ++mt)
#pragma unroll
            for (int nt = 0; nt < 4; ++nt) {
                const int row = row0 + mt * 16 + fr, col = col0 + nt * 16 + fq * 4;
                *(u32x2*)(C + (size_t)row * ldc + col) = pack4(acc[mt][nt]);
            }
    }
};
struct EpiSSMIn {
    bf16_t* ZXB; float* DTRAW;
    __device__ __forceinline__ void operator()(f32x4 (&acc)[4][4], int row0, int col0, int fr, int fq) const {
#pragma unroll
        for (int mt = 0; mt < 4; ++mt)
#pragma unroll
            for (int nt = 0; nt < 4; ++nt) {
                const int row = row0 + mt * 16 + fr, col = col0 + nt * 16 + fq * 4;
                if (col < 5120) *(u32x2*)(ZXB + (size_t)row * 5120 + col) = pack4(acc[mt][nt]);
                else if (col < 5184) *(f32x4*)(DTRAW + (size_t)row * 64 + (col - 5120)) = acc[mt][nt];
            }
    }
};
struct EpiQ {
    bf16_t* Q; const float* rope; float qscale;
    __device__ __forceinline__ void operator()(f32x4 (&acc)[4][4], int row0, int col0, int fr, int fq) const {
#pragma unroll
        for (int mt = 0; mt < 4; ++mt) {
            const int row = row0 + mt * 16 + fr;
            const int pos = (row - 4096) & 2047;
#pragma unroll
            for (int nt = 0; nt < 4; ++nt) {
                const int c16 = col0 + nt * 16, d16 = c16 % 96;
                f32x4 v = acc[mt][nt];
                if (row0 >= 4096 && d16 >= 64) {
                    const int axis = (d16 - 64) >> 4, ph = fq >> 1, f0 = (fq & 1) * 4;
                    f32x4 pr;
#pragma unroll
                    for (int e = 0; e < 4; ++e) pr[e] = __shfl_xor(v[e], 32);
                    const f32x4 cs = *(const f32x4*)(rope + pos * 32 + axis * 8 + f0), sn = *(const f32x4*)(rope + pos * 32 + 16 + axis * 8 + f0);
#pragma unroll
                    for (int e = 0; e < 4; ++e) v[e] = ph == 0 ? v[e] * cs[e] - pr[e] * sn[e] : v[e] * cs[e] + pr[e] * sn[e];
                }
#pragma unroll
                for (int e = 0; e < 4; ++e) v[e] *= qscale;
                *(u32x2*)(Q + (size_t)row * 1536 + c16 + fq * 4) = pack4(v);
            }
        }
    }
};

template <class Epi>
__device__ __forceinline__ void gemm_tiles(const bf16_t* A, int lda, const bf16_t* Bt, int ldb, int M, int N, int K, const Epi& epi, unsigned char* smem, int rot) {
    constexpr int AS = 72;
    bf16_t* As = (bf16_t*)smem;
    bf16_t* Bs = As + 2 * 256 * AS;
    const int tid = tid_opaque(), wid = __builtin_amdgcn_readfirstlane(tid >> 6), lane = tid & 63, fr = lane & 15, fq = lane >> 4;
    const int wm = wid >> 1, wn = wid & 1;
    const int nM = M >> 8, nN = N >> 7, nT = nM * nN, nk = K >> 6;
    const int G = gridDim.x;
    const int b = (bid_opaque() + G - (rot % G)) % G;
    const int lr = tid >> 3, lc = (tid & 7) * 8;
    for (int t = b; t < nT; t += G) {
        const int tn = t / nM, tm = t % nM;
        const bf16_t* Ag = A + (size_t)(tm * 256 + lr) * lda + lc;
        const bf16_t* Bg = Bt + (size_t)(tn * 128 + lr) * ldb + lc;
        __syncthreads();
        f32x4 acc[4][4];
#pragma unroll
        for (int i = 0; i < 4; ++i)
#pragma unroll
            for (int j = 0; j < 4; ++j) acc[i][j] = (f32x4){0.f, 0.f, 0.f, 0.f};
        u32x4 ra0[4], rb0[2], ra1[4], rb1[2];
#define G_LOAD(RA, RB, kt_) { _Pragma("unroll") for (int i = 0; i < 4; ++i) RA[i] = *(const u32x4*)(Ag + (size_t)(64 * i) * lda + (kt_) * 64); \
                              _Pragma("unroll") for (int i = 0; i < 2; ++i) RB[i] = *(const u32x4*)(Bg + (size_t)(64 * i) * ldb + (kt_) * 64); }
#define G_STORE(RA, RB, buf_) { _Pragma("unroll") for (int i = 0; i < 4; ++i) *(u32x4*)(As + ((buf_) * 256 + lr + 64 * i) * AS + lc) = RA[i]; \
                                _Pragma("unroll") for (int i = 0; i < 2; ++i) *(u32x4*)(Bs + ((buf_) * 128 + lr + 64 * i) * AS + lc) = RB[i]; }
#define G_COMPUTE(cur_) { const bf16_t* Ac = As + ((cur_) * 256 + wm * 64 + fr) * AS + fq * 8; const bf16_t* Bc = Bs + ((cur_) * 128 + wn * 64 + fr) * AS + fq * 8; \
            _Pragma("unroll") for (int ks = 0; ks < 2; ++ks) { bf16x8 af[4], bfr[4]; \
                _Pragma("unroll") for (int mt = 0; mt < 4; ++mt) af[mt] = *(const bf16x8*)(Ac + mt * 16 * AS + ks * 32); \
                _Pragma("unroll") for (int nt = 0; nt < 4; ++nt) bfr[nt] = *(const bf16x8*)(Bc + nt * 16 * AS + ks * 32); \
                _Pragma("unroll") for (int mt = 0; mt < 4; ++mt) _Pragma("unroll") for (int nt = 0; nt < 4; ++nt) acc[mt][nt] = mfma16(bfr[nt], af[mt], acc[mt][nt]); } }
        G_LOAD(ra0, rb0, 0);
        G_LOAD(ra1, rb1, 1);
        G_STORE(ra0, rb0, 0);
        __syncthreads();
        for (int kt = 0; kt < nk; kt += 2) {
            { const int k2 = kt + 2 < nk ? kt + 2 : kt; G_LOAD(ra0, rb0, k2); }
            G_COMPUTE(0);
            G_STORE(ra1, rb1, 1);
            __syncthreads();
            { const int k3 = kt + 3 < nk ? kt + 3 : kt + 1; G_LOAD(ra1, rb1, k3); }
            G_COMPUTE(1);
            if (kt + 2 < nk) G_STORE(ra0, rb0, 0);
            __syncthreads();
        }
#undef G_LOAD
#undef G_STORE
#undef G_COMPUTE
        epi(acc, tm * 256 + wm * 64, tn * 128 + wn * 64, fr, fq);
    }
}


namespace pg8 {
#define PG8_LAS __attribute__((address_space(3)))
constexpr int BM = 256, BK = 64, HALF = 128, HTB = HALF * BK * 2, NXCD = 8, WGM = 8;
__device__ __forceinline__ int lds_byte(int r, int c) { const int st = (r >> 4) * 2 + (c >> 5), rr = r & 15, cc = c & 31, ob = rr * 64 + cc * 2; return st * 1024 + (ob ^ (((ob >> 9) & 1) << 5)); }
__device__ __forceinline__ void stage_rc(int b, int& R, int& C) { const int st = b / 1024, sb = b % 1024, swz = sb ^ (((sb >> 9) & 1) << 5); R = (st >> 1) * 16 + swz / 64; C = (st & 1) * 32 + (swz % 64) / 2; }
__device__ __forceinline__ int perm32(int rho) { const int n = rho >> 4, i = rho & 15; return 8 * (i >> 2) + 4 * n + (i & 3); }
struct Unit { int pm, pn; };
struct StaticOrder {
    int nM, nN, nwg, G, c;
    __device__ void init(int M, int N, int G_, int c_) { nM = M / BM; nN = N / BM; nwg = nM * nN; G = G_; c = c_; }
    __device__ bool next(int i, Unit& u) const {
        const long L = (long)i * G + c; if (L >= nwg) return false;
        int wgid = (int)L; { const int q = nwg / NXCD, r = nwg % NXCD, xcd = wgid % NXCD, off = wgid / NXCD; wgid = (xcd < r ? xcd * (q + 1) : r * (q + 1) + (xcd - r) * q) + off; }
        const int nig = WGM * nN, gid = wgid / nig, fm = gid * WGM, gsz = (nM - fm) < WGM ? (nM - fm) : WGM;
        u.pm = fm + ((wgid % nig) % gsz); u.pn = (wgid % nig) / gsz; return true;
    }
};
template <class Epi, class Sched>
__device__ __forceinline__ void gemm_phase(PG8_LAS unsigned char* lds, const bf16_t* A, const bf16_t* Bt, int K, const Sched& S, const Epi& E) {
    const int tid = tid_opaque(), wid = __builtin_amdgcn_readfirstlane(tid >> 6), lane = tid & 63, wr = wid >> 2, wc = wid & 3, fr = lane & 15, fq = lane >> 4;
    const int nt = K / BK;
    unsigned voffA[2], voffB[2];
#pragma unroll
    for (int i = 0; i < 2; ++i) { int R, C; stage_rc(tid * 16 + i * 8192, R, C); const int Rb = Epi::PERM ? ((R & ~31) + perm32(R & 31)) : R;
        voffA[i] = (unsigned)(R * K + C) * 2u; voffB[i] = (unsigned)(Rb * K + C) * 2u; }
    const size_t kstep = (size_t)(BK * 2);
    const size_t hstep = (size_t)HALF * K * 2;
    const size_t tstep = 2 * hstep;
    const unsigned ldsw = (unsigned)wid * 1024u;
    const int aoff = lds_byte(wr * 64 + fr, fq * 8), boff = lds_byte(wc * 32 + fr, fq * 8);
#define PG8_SA(b, h) (((b) * 2 + (h)) * HTB)
#define PG8_SB(b, h) ((4 + (b) * 2 + (h)) * HTB)
#define PG8_STAGE(bufoff, gbase, voff) do { _Pragma("unroll") for (int _i = 0; _i < 2; ++_i) \
        __builtin_amdgcn_global_load_lds((const unsigned*)((const char*)(gbase) + (voff)[_i]), (PG8_LAS unsigned*)(lds + (bufoff) + ldsw + _i * 8192), 16, 0, 0); } while (0)
#define PG8_LDA(dst, b, h) do { _Pragma("unroll") for (int m = 0; m < 4; ++m) _Pragma("unroll") for (int k = 0; k < 2; ++k) dst[m][k] = *(const PG8_LAS bf16x8*)(lds + PG8_SA(b, h) + aoff + m * 2048 + k * 1024); } while (0)
#define PG8_LDB(dst, b, h) do { _Pragma("unroll") for (int n = 0; n < 2; ++n) _Pragma("unroll") for (int k = 0; k < 2; ++k) dst[n][k] = *(const PG8_LAS bf16x8*)(lds + PG8_SB(b, h) + boff + n * 2048 + k * 1024); } while (0)
#define PG8_MMA(ai, bj, At, Bt) do { __builtin_amdgcn_s_setprio(1); _Pragma("unroll") for (int m = 0; m < 4; ++m) _Pragma("unroll") for (int n = 0; n < 2; ++n) _Pragma("unroll") for (int k = 0; k < 2; ++k) \
        acc[ai][bj][m][n] = __builtin_amdgcn_mfma_f32_16x16x32_bf16(Bt[n][k], At[m][k], acc[ai][bj][m][n], 0, 0, 0); __builtin_amdgcn_s_setprio(0); } while (0)
#define PG8_WAIT_V(n) asm volatile("s_waitcnt vmcnt(" #n ")" ::: "memory")
#define PG8_WAIT_L(n) asm volatile("s_waitcnt lgkmcnt(" #n ")" ::: "memory")
#define PG8_BAR __builtin_amdgcn_s_barrier()
#define PG8_SCHED __builtin_amdgcn_sched_barrier(0)
    Unit cur, nxt; int ui = 0;
    if (!S.next(0, cur)) return;
    f32x4 acc[2][2][4][2];
#pragma unroll
    for (int a = 0; a < 2; ++a)
#pragma unroll
        for (int b = 0; b < 2; ++b)
#pragma unroll
            for (int m = 0; m < 4; ++m)
#pragma unroll
                for (int n = 0; n < 2; ++n) acc[a][b][m][n] = (f32x4){0.f, 0.f, 0.f, 0.f};
    bf16x8 At[4][2], B0[2][2], B1[2][2];
    const char* cA = (const char*)A + (size_t)cur.pm * tstep; const char* cB = (const char*)Bt + (size_t)cur.pn * tstep;
    PG8_STAGE(PG8_SB(0, 0), cB, voffB); PG8_STAGE(PG8_SA(0, 0), cA, voffA); PG8_STAGE(PG8_SB(0, 1), cB + hstep, voffB); PG8_STAGE(PG8_SA(0, 1), cA + hstep, voffA);
    if (wr == 1) PG8_BAR;
    PG8_WAIT_V(4); PG8_BAR;
    PG8_STAGE(PG8_SB(1, 0), cB + kstep, voffB); PG8_STAGE(PG8_SA(1, 0), cA + kstep, voffA); PG8_STAGE(PG8_SB(1, 1), cB + hstep + kstep, voffB);
    PG8_WAIT_V(6); PG8_BAR;
    for (;;) {
        const bool has_next = S.next(ui + 1, nxt);
        const char* nA = has_next ? (const char*)A + (size_t)nxt.pm * tstep : cA; const char* nB = has_next ? (const char*)Bt + (size_t)nxt.pn * tstep : cB;
        for (int t = 0; t < nt; t += 2) {
            const bool last = (t == nt - 2);
            const char* a1 = cA + (size_t)(t + 1) * kstep;
            const char* a2 = last ? nA : cA + (size_t)(t + 2) * kstep; const char* b2 = last ? nB : cB + (size_t)(t + 2) * kstep;
            const char* a3 = a2 + kstep; const char* b3 = b2 + kstep;
            PG8_LDB(B0, 0, 0); PG8_SCHED; PG8_LDA(At, 0, 0); PG8_STAGE(PG8_SA(1, 1), a1 + hstep, voffA);
            PG8_WAIT_L(8); PG8_BAR; PG8_WAIT_L(0); PG8_MMA(0, 0, At, B0); PG8_BAR; PG8_SCHED;
            PG8_LDB(B1, 0, 1); PG8_STAGE(PG8_SB(0, 0), b2, voffB);
            PG8_BAR; PG8_WAIT_L(0); PG8_MMA(0, 1, At, B1); PG8_BAR;
            PG8_LDA(At, 0, 1); PG8_STAGE(PG8_SA(0, 0), a2, voffA);
            PG8_BAR; PG8_WAIT_L(0); PG8_MMA(1, 0, At, B0); PG8_BAR; PG8_SCHED;
            PG8_STAGE(PG8_SB(0, 1), b2 + hstep, voffB);
            PG8_WAIT_V(6); PG8_BAR; PG8_MMA(1, 1, At, B1); PG8_BAR;
            PG8_LDB(B0, 1, 0); PG8_SCHED; PG8_LDA(At, 1, 0); PG8_STAGE(PG8_SA(0, 1), a2 + hstep, voffA);
            PG8_WAIT_L(8); PG8_BAR; PG8_WAIT_L(0); PG8_MMA(0, 0, At, B0); PG8_BAR; PG8_SCHED;
            PG8_LDB(B1, 1, 1); PG8_STAGE(PG8_SB(1, 0), b3, voffB);
            PG8_BAR; PG8_WAIT_L(0); PG8_MMA(0, 1, At, B1); PG8_BAR;
            PG8_LDA(At, 1, 1); PG8_STAGE(PG8_SA(1, 0), a3, voffA);
            PG8_BAR; PG8_WAIT_L(0); PG8_MMA(1, 0, At, B0); PG8_BAR; PG8_SCHED;
            PG8_STAGE(PG8_SB(1, 1), b3 + hstep, voffB);
            PG8_WAIT_V(6); PG8_BAR; PG8_MMA(1, 1, At, B1); PG8_BAR;
        }
        E(acc, cur, wr, wc, fr, fq);
        if (!has_next) break;
#pragma unroll
        for (int a = 0; a < 2; ++a)
#pragma unroll
            for (int b = 0; b < 2; ++b)
#pragma unroll
                for (int m = 0; m < 4; ++m)
#pragma unroll
                    for (int n = 0; n < 2; ++n) acc[a][b][m][n] = (f32x4){0.f, 0.f, 0.f, 0.f};
        cur = nxt; cA = nA; cB = nB; ++ui;
    }
    PG8_WAIT_V(0);
    if (wr == 0) PG8_BAR;
    PG8_BAR;
#undef PG8_SA
#undef PG8_SB
#undef PG8_STAGE
#undef PG8_LDA
#undef PG8_LDB
#undef PG8_MMA
#undef PG8_WAIT_V
#undef PG8_WAIT_L
#undef PG8_BAR
#undef PG8_SCHED
}
}

struct Epi8SwiGLU {
    static constexpr bool PERM = false;
    bf16_t* U;
    __device__ __forceinline__ void operator()(const f32x4 (&acc)[2][2][4][2], const pg8::Unit& u, int wr, int wc, int fr, int fq) const {
#pragma unroll
        for (int ai = 0; ai < 2; ++ai)
#pragma unroll
            for (int m = 0; m < 4; ++m) {
                const int row = u.pm * 256 + ai * 128 + wr * 64 + m * 16 + fr;
#pragma unroll
                for (int n = 0; n < 2; ++n) {
                    f32x4 o;
#pragma unroll
                    for (int e = 0; e < 4; ++e) o[e] = silu_f(acc[ai][0][m][n][e]) * acc[ai][1][m][n][e];
                    *(u32x2*)(U + (size_t)row * DFF + u.pn * 128 + wc * 32 + n * 16 + fq * 4) = pack4(o);
                }
            }
    }
};
struct Epi8SSMIn {
    static constexpr bool PERM = false;
    bf16_t* ZXB; float* DTRAW;
    __device__ __forceinline__ void operator()(const f32x4 (&acc)[2][2][4][2], const pg8::Unit& u, int wr, int wc, int fr, int fq) const {
#pragma unroll
        for (int ai = 0; ai < 2; ++ai)
#pragma unroll
            for (int m = 0; m < 4; ++m) {
                const int row = u.pm * 256 + ai * 128 + wr * 64 + m * 16 + fr;
#pragma unroll
                for (int bj = 0; bj < 2; ++bj)
#pragma unroll
                    for (int n = 0; n < 2; ++n) {
                        const int col = u.pn * 256 + bj * 128 + wc * 32 + n * 16 + fq * 4;
                        if (col < 5120) *(u32x2*)(ZXB + (size_t)row * 5120 + col) = pack4(acc[ai][bj][m][n]);
                        else if (col < 5184) *(f32x4*)(DTRAW + (size_t)row * 64 + (col - 5120)) = acc[ai][bj][m][n];
                    }
            }
    }
};

__device__ __forceinline__ void phase_mlanorm(const float* __restrict__ QKVA, const float* __restrict__ qn, const float* __restrict__ kvn, const float* __restrict__ cache, int j,
                              const float* __restrict__ rope, bf16_t* __restrict__ QA, bf16_t* __restrict__ CKV, bf16_t* __restrict__ KR, float* __restrict__ out_cache) {
    const int tid_ = tid_opaque(); const int lane = tid_ & 63, gw = bid_opaque() * 8 + (tid_ >> 6), nW = gridDim.x * 8;
    for (int tok = gw; tok < NTOKKV; tok += nW) {
        if (tok < NTOK) {
            const float* r = QKVA + (size_t)tok * 800;
            const f32x4 q0 = *(const f32x4*)(r + lane * 4), q1 = *(const f32x4*)(r + 256 + lane * 4), kv = *(const f32x4*)(r + 512 + lane * 4);
            const float kr = lane < 32 ? r[768 + lane] : 0.f;
            float sq = 0.f, sk = 0.f;
#pragma unroll
            for (int e = 0; e < 4; ++e) { sq += q0[e] * q0[e] + q1[e] * q1[e]; sk += kv[e] * kv[e]; }
            const float rq = rsqrtf(wave_sum(sq) * (1.f / 512) + EPS), rk = rsqrtf(wave_sum(sk) * (1.f / 256) + EPS);
            const f32x4 g0 = *(const f32x4*)(qn + lane * 4), g1 = *(const f32x4*)(qn + 256 + lane * 4), gk = *(const f32x4*)(kvn + lane * 4);
            f32x4 a0, a1, ck;
#pragma unroll
            for (int e = 0; e < 4; ++e) { a0[e] = q0[e] * rq * g0[e]; a1[e] = q1[e] * rq * g1[e]; ck[e] = kv[e] * rk * gk[e]; }
            *(u32x2*)(QA + (size_t)tok * 512 + lane * 4) = pack4(a0);
            *(u32x2*)(QA + (size_t)tok * 512 + 256 + lane * 4) = pack4(a1);
            *(u32x2*)(CKV + (size_t)tok * 256 + lane * 4) = pack4(ck);
            float krv = kr;
            if (tok < 4096) {
                float* o = out_cache + ((size_t)((tok >> 8) * 2 + j) * 256 + (tok & 255)) * 288;
                *(f32x4*)(o + lane * 4) = ck;
                if (lane < 32) o[256 + lane] = kr;
            } else {
                const int pos = (tok - 4096) & 2047;
                const float partner = __shfl_xor(kr, 8);
                const int l31 = lane & 31, axis = l31 >> 4, ph = (l31 >> 3) & 1, f = l31 & 7;
                const float cs = rope[pos * 32 + axis * 8 + f], sn = rope[pos * 32 + 16 + axis * 8 + f];
                krv = ph == 0 ? kr * cs - partner * sn : kr * cs + partner * sn;
            }
            if (lane < 32) KR[(size_t)tok * 32 + lane] = f2bf(krv);
        } else {
            const int ct = tok - NTOK, bb = ct >> 8, pp = ct & 255;
            const float* c = cache + ((size_t)(bb * 2 + j) * 256 + pp) * 288;
            const f32x4 kv = *(const f32x4*)(c + lane * 4);
            *(u32x2*)(CKV + (size_t)tok * 256 + lane * 4) = pack4(kv);
            if (lane < 32) KR[(size_t)tok * 32 + lane] = f2bf(c[256 + lane]);
        }
    }
}

__device__ __forceinline__ void phase_attn(const bf16_t* __restrict__ Q, const bf16_t* __restrict__ KN, const bf16_t* __restrict__ KR, const bf16_t* __restrict__ VT, bf16_t* __restrict__ O, unsigned char* smem) {
    constexpr int KS = 104, VS = 72;
    bf16_t* Ks = (bf16_t*)smem;
    bf16_t* Vs = Ks + 2 * 64 * KS;
    const int tid = tid_opaque(), wid = __builtin_amdgcn_readfirstlane(tid >> 6), lane = tid & 63, fr = lane & 15, fq = lane >> 4;
    const int G = gridDim.x, b = bid_opaque();
    const int lrow = tid >> 3, lc8 = (tid & 7) * 8, rrow = (tid >> 2) & 63, rc8 = (tid & 3) * 8;
    for (int it = 0;; ++it) {
        const int idx = (it >> 1) * G + b;
        if (idx >= 256) break;
        const bool samp = (it & 1) == 0;
        int head, q0, nkt, sb = 0, kbase = 0;
        if (samp) { sb = idx >> 7; const int rem = idx & 127; head = rem >> 3; q0 = 4096 + sb * 2048 + (rem & 7) * 256; nkt = 36; }
        else { const int seq = idx >> 4; head = idx & 15; q0 = seq * 256; nkt = 4; kbase = seq * 256; }
        bf16x8 qf[2][3];
#pragma unroll
        for (int g = 0; g < 2; ++g)
#pragma unroll
            for (int ks = 0; ks < 3; ++ks) qf[g][ks] = *(const bf16x8*)(Q + (size_t)(q0 + wid * 32 + g * 16 + fr) * 1536 + head * 96 + ks * 32 + fq * 8);
        f32x4 ot[2][4];
#pragma unroll
        for (int g = 0; g < 2; ++g)
#pragma unroll
            for (int i = 0; i < 4; ++i) ot[g][i] = (f32x4){0.f, 0.f, 0.f, 0.f};
        float m[2] = {-1e30f, -1e30f}, l[2] = {0.f, 0.f};
        u32x4 rk, rr = {0u, 0u, 0u, 0u}, rv;
#define ATT_TB(kt) (samp ? ((kt) < 4 ? NTOK + sb * 256 + (kt) * 64 : 4096 + sb * 2048 + ((kt) - 4) * 64) : kbase + (kt) * 64)
#define ATT_GLOAD(kt) { const int tb = ATT_TB(kt); rk = *(const u32x4*)(KN + (size_t)(tb + lrow) * 1024 + head * 64 + lc8); \
            if (tid < 256) rr = *(const u32x4*)(KR + (size_t)(tb + rrow) * 32 + rc8); \
            rv = *(const u32x4*)(VT + (size_t)(head * 64 + lrow) * NTOKKV + tb + lc8); }
#define ATT_LSTORE(buf) { *(u32x4*)(Ks + ((buf) * 64 + lrow) * KS + lc8) = rk; if (tid < 256) *(u32x4*)(Ks + ((buf) * 64 + rrow) * KS + 64 + rc8) = rr; \
            *(u32x4*)(Vs + ((buf) * 64 + lrow) * VS + lc8) = rv; }
        ATT_GLOAD(0); ATT_LSTORE(0);
        __syncthreads();
#pragma unroll 1
        for (int kt = 0; kt < nkt; ++kt) {
            const int cur = kt & 1;
            if (kt + 1 < nkt) ATT_GLOAD(kt + 1);
            f32x4 st[2][4];
#pragma unroll
            for (int jt = 0; jt < 4; ++jt) {
                st[0][jt] = (f32x4){0.f, 0.f, 0.f, 0.f}; st[1][jt] = (f32x4){0.f, 0.f, 0.f, 0.f};
#pragma unroll
                for (int ks = 0; ks < 3; ++ks) {
                    const bf16x8 a = *(const bf16x8*)(Ks + (cur * 64 + jt * 16 + fr) * KS + ks * 32 + fq * 8);
                    st[0][jt] = mfma16(a, qf[0][ks], st[0][jt]);
                    st[1][jt] = mfma16(a, qf[1][ks], st[1][jt]);
                }
                asm volatile("" ::: "memory");
            }
            union { u32x4 u; bf16x8 v; } pb[2][2];
#pragma unroll
            for (int g = 0; g < 2; ++g) {
                float mloc = st[g][0][0];
#pragma unroll
                for (int jt = 0; jt < 4; ++jt)
#pragma unroll
                    for (int e = 0; e < 4; ++e) mloc = fmaxf(mloc, st[g][jt][e]);
                mloc = fmaxf(mloc, __shfl_xor(mloc, 16)); mloc = fmaxf(mloc, __shfl_xor(mloc, 32));
                const float mn = fmaxf(m[g], mloc), alpha = __builtin_amdgcn_exp2f(m[g] - mn);
                m[g] = mn;
                float psum = 0.f;
#pragma unroll
                for (int jt = 0; jt < 4; ++jt)
#pragma unroll
                    for (int e = 0; e < 4; ++e) { st[g][jt][e] = __builtin_amdgcn_exp2f(st[g][jt][e] - mn); psum += st[g][jt][e]; }
                l[g] = l[g] * alpha + psum;
#pragma unroll
                for (int i = 0; i < 4; ++i) ot[g][i] *= alpha;
#pragma unroll
                for (int s = 0; s < 2; ++s) {
                    pb[g][s].u.x = pk2(st[g][2 * s][0], st[g][2 * s][1]); pb[g][s].u.y = pk2(st[g][2 * s][2], st[g][2 * s][3]);
                    pb[g][s].u.z = pk2(st[g][2 * s + 1][0], st[g][2 * s + 1][1]); pb[g][s].u.w = pk2(st[g][2 * s + 1][2], st[g][2 * s + 1][3]);
                }
            }
#pragma unroll
            for (int s = 0; s < 2; ++s)
#pragma unroll
                for (int dvt = 0; dvt < 4; ++dvt) {
                    const bf16_t* vp = Vs + (cur * 64 + dvt * 16 + fr) * VS + s * 32 + fq * 4;
                    union { u32x4 u; bf16x8 v; } va;
                    const u32x2 lo = *(const u32x2*)vp, hi = *(const u32x2*)(vp + 16);
                    va.u.x = lo.x; va.u.y = lo.y; va.u.z = hi.x; va.u.w = hi.y;
                    ot[0][dvt] = mfma16(va.v, pb[0][s].v, ot[0][dvt]);
                    ot[1][dvt] = mfma16(va.v, pb[1][s].v, ot[1][dvt]);
                    asm volatile("" ::: "memory");
                }
            if (kt + 1 < nkt) ATT_LSTORE(cur ^ 1);
            __syncthreads();
        }
#pragma unroll
        for (int g = 0; g < 2; ++g) {
            float lt = l[g];
            lt += __shfl_xor(lt, 16); lt += __shfl_xor(lt, 32);
            const float inv = 1.f / lt;
#pragma unroll
            for (int dvt = 0; dvt < 4; ++dvt) {
                f32x4 o = ot[g][dvt] * inv;
                *(u32x2*)(O + (size_t)(q0 + wid * 32 + g * 16 + fr) * 1024 + head * 64 + dvt * 16 + fq * 4) = pack4(o);
            }
        }
    }
#undef ATT_TB
#undef ATT_GLOAD
#undef ATT_LSTORE
}


__device__ __forceinline__ void phase_conv(const bf16_t* __restrict__ ZXB, const float* __restrict__ DTRAW, const float* __restrict__ cw, const float* __restrict__ cb, const float* __restrict__ dtb,
                           bf16_t* __restrict__ XS, bf16_t* __restrict__ XT, bf16_t* __restrict__ BM, bf16_t* __restrict__ BT, bf16_t* __restrict__ CM, float* __restrict__ DT, unsigned char* smem) {
    float* in = (float*)smem;
    bf16_t* ot = (bf16_t*)(smem + 34560);
    const int tid = tid_opaque(), G = gridDim.x;
    u32x4 pv[3];
#define CONV_LOAD(item_) { const int chunk_ = (item_) / 48, slab_ = (item_) % 48, t0_ = chunk_ * 128; int lo_, hi_; \
        if (chunk_ < 32) { lo_ = (chunk_ >> 1) * 256; hi_ = lo_ + 256; } else { lo_ = 4096 + ((chunk_ - 32) >> 4) * 2048; hi_ = lo_ + 2048; } \
        _Pragma("unroll") for (int k = 0; k < 3; ++k) { const int c = tid + k * NT, r = c >> 3, kc = c & 7, t = t0_ - 2 + r; pv[k] = (u32x4){0u, 0u, 0u, 0u}; \
            if (c < 132 * 8 && t >= lo_ && t < hi_) pv[k] = *(const u32x4*)(ZXB + (size_t)t * 5120 + 2048 + slab_ * 64 + kc * 8); } }
    const int item0 = bid_opaque();
    if (item0 < 64 * 48) CONV_LOAD(item0);
    for (int item = item0; item < 64 * 48; item += G) {
        const int chunk = item / 48, slab = item % 48, t0 = chunk * 128;
#pragma unroll
        for (int k = 0; k < 3; ++k) {
            const int c = tid + k * NT, r = c >> 3, kc = c & 7;
            if (c < 132 * 8) {
                const u32x4 v = pv[k];
                float* d = in + r * 65 + kc * 8;
                d[0] = bflo(v.x); d[1] = bfhi(v.x); d[2] = bflo(v.y); d[3] = bfhi(v.y); d[4] = bflo(v.z); d[5] = bfhi(v.z); d[6] = bflo(v.w); d[7] = bfhi(v.w);
            }
        }
        __syncthreads();
        if (item + G < 64 * 48) CONV_LOAD(item + G);
        {
            const int ch = tid & 63, tg = tid >> 6, cg_ = slab * 64 + ch;
            const float w0 = cw[cg_], w1 = cw[3072 + cg_], w2 = cw[2 * 3072 + cg_], w3 = cw[3 * 3072 + cg_], w4 = cw[4 * 3072 + cg_], bias = cb[cg_];
            const float* ip = in + (tg * 16) * 65 + ch;
            float x0 = ip[0], x1 = ip[65], x2 = ip[130], x3 = ip[195];
#pragma unroll
            for (int tt = 0; tt < 16; ++tt) {
                const float x4 = ip[(tt + 4) * 65];
                const float a = bias + x0 * w0 + x1 * w1 + x2 * w2 + x3 * w3 + x4 * w4;
                ot[(tg * 16 + tt) * 66 + ch] = f2bf(silu_f(a));
                x0 = x1; x1 = x2; x2 = x3; x3 = x4;
            }
        }
        __syncthreads();
        bf16_t* dst; int ld, col; bf16_t* tdst = nullptr;
        if (slab < 32) { dst = nullptr; ld = 2048; col = slab * 64; tdst = XT + ((size_t)chunk * 2048 + slab * 64) * 128; }
        else if (slab < 40) { dst = BM; ld = 512; col = (slab - 32) * 64; tdst = BT + ((size_t)chunk * 512 + (slab - 32) * 64) * 128; }
        else { dst = CM; ld = 512; col = (slab - 40) * 64; }
        if (dst) {
#pragma unroll
        for (int i = 0; i < 2; ++i) {
            const int c = tid + i * NT, r = c >> 3, kc = c & 7;
            const unsigned* s32 = (const unsigned*)ot + r * 33 + kc * 4;
            u32x4 o; o.x = s32[0]; o.y = s32[1]; o.z = s32[2]; o.w = s32[3];
            *(u32x4*)(dst + (size_t)(t0 + r) * ld + col + kc * 8) = o;
        }
        }
        if (tdst) {
#pragma unroll
            for (int i = 0; i < 2; ++i) {
                const int c = tid + i * NT, chh = c >> 4, jc = c & 15;
                const bf16_t* s = ot + (jc * 8) * 66 + chh;
                u32x4 o;
                o.x = (unsigned)s[0] | ((unsigned)s[66] << 16); o.y = (unsigned)s[2 * 66] | ((unsigned)s[3 * 66] << 16);
                o.z = (unsigned)s[4 * 66] | ((unsigned)s[5 * 66] << 16); o.w = (unsigned)s[6 * 66] | ((unsigned)s[7 * 66] << 16);
                *(u32x4*)(tdst + (size_t)chh * 128 + jc * 8) = o;
            }
        }
    }
#undef CONV_LOAD
    __syncthreads();
    for (int i = bid_opaque() * NT + tid; i < NTOK * 64; i += G * NT) {
        const float v = DTRAW[i] + dtb[i & 63];
        DT[i] = v > 20.f ? v : log1pf(__expf(v));
    }
}

__device__ __forceinline__ void phase_ssd(const bf16_t* __restrict__ XT, const bf16_t* __restrict__ BM, const bf16_t* __restrict__ BT, const bf16_t* __restrict__ CM, const float* __restrict__ DT,
                          const float* __restrict__ a_log, const float* __restrict__ state_in, int j, bf16_t* __restrict__ YF, bf16_t* __restrict__ YB, float* __restrict__ out_state, unsigned char* smem, const float* __restrict__ dsk) {
    constexpr int LS = 136;
    bf16_t* Cs = (bf16_t*)smem;
    bf16_t* Bs = Cs + 128 * LS;
    bf16_t* BTs = Bs + 128 * LS;
    bf16_t* XTs = BTs + 128 * LS;
    bf16_t* Hs = XTs + 64 * LS;
    float* cum = (float*)(Hs + 64 * LS);
    float* dts = cum + 128;
    float* wj = dts + 128;
    float* misc = wj + 128;
    const int tid = tid_opaque(), wid = __builtin_amdgcn_readfirstlane(tid >> 6), lane = tid & 63, fr = lane & 15, fq = lane >> 4;
    const int G = gridDim.x;
    const int strip = wid < 4 ? wid : 11 - wid;
    const int pt = wid & 3, nt0 = (wid >> 2) * 4;
    const int lr = tid >> 4, lc = (tid & 15) * 8;
    const int irow = strip * 16 + fr;
    for (int w = bid_opaque(); w < 256; w += G) {
        const bool samp = w < 128;
#define SSD_DECODE(step_, seq_, dir_, head_, t0_, first_, last_) { \
            if (samp) { seq_ = w >> 6; dir_ = (w >> 5) & 1; head_ = w & 31; const int c_ = dir_ ? 15 - (step_) : (step_); t0_ = 4096 + seq_ * 2048 + c_ * 128; first_ = (step_) == 0; last_ = (step_) == 15; } \
            else { const int pu_ = (w - 128) * 8 + ((step_) >> 1); seq_ = pu_ >> 6; dir_ = (pu_ >> 5) & 1; head_ = pu_ & 31; const int cc_ = (step_) & 1, c_ = dir_ ? 1 - cc_ : cc_; t0_ = seq_ * 256 + c_ * 128; first_ = cc_ == 0; last_ = cc_ == 1; } }
        u32x4 rC[4], rB[4], rBT[4], rX[2]; float rd0 = 0.f, rd1 = 0.f;
#define SSD_ISSUE(step_) { int seq_n, dir_n, head_n, t0_n; bool f_n, l_n; SSD_DECODE(step_, seq_n, dir_n, head_n, t0_n, f_n, l_n); (void)f_n; (void)l_n; (void)seq_n; \
            const int grp_n = head_n >> 3, chunk_n = t0_n >> 7; \
            if (wid == 0) { rd0 = DT[(size_t)(t0_n + lane) * 64 + dir_n * 32 + head_n]; rd1 = DT[(size_t)(t0_n + 64 + lane) * 64 + dir_n * 32 + head_n]; } \
            _Pragma("unroll") for (int i = 0; i < 4; ++i) { const int r = lr + 32 * i; \
                rC[i] = *(const u32x4*)(CM + (size_t)(t0_n + r) * 512 + grp_n * 128 + lc); \
                rB[i] = *(const u32x4*)(BM + (size_t)(t0_n + r) * 512 + grp_n * 128 + lc); \
                rBT[i] = *(const u32x4*)(BT + ((size_t)chunk_n * 512 + grp_n * 128 + r) * 128 + lc); } \
            _Pragma("unroll") for (int i = 0; i < 2; ++i) { const int r = lr + 32 * i; rX[i] = *(const u32x4*)(XT + ((size_t)chunk_n * 2048 + head_n * 64 + r) * 128 + lc); } }
        SSD_ISSUE(0);
        f32x4 hacc[4];
#pragma unroll
        for (int k = 0; k < 4; ++k) hacc[k] = (f32x4){0.f, 0.f, 0.f, 0.f};
        for (int step = 0; step < 16; ++step) {
            int seq, dir, head, t0; bool first, last;
            SSD_DECODE(step, seq, dir, head, t0, first, last);
            const float A2 = -__expf(a_log[dir * 32 + head]) * 1.44269504f;
            bf16_t* Y = dir ? YB : YF;
            const size_t sbase = ((((size_t)(seq * 2 + j) * 2 + dir) * 32 + head) * 64 + pt * 16 + fr) * 128 + fq * 4;
            if (first) {
#pragma unroll
                for (int k = 0; k < 4; ++k) hacc[k] = samp ? *(const f32x4*)(state_in + sbase + (nt0 + k) * 16) : (f32x4){0.f, 0.f, 0.f, 0.f};
            }
#pragma unroll
            for (int k = 0; k < 4; ++k) *(u32x2*)(Hs + (pt * 16 + fr) * LS + (nt0 + k) * 16 + fq * 4) = pack4(hacc[k]);
#pragma unroll
            for (int i = 0; i < 4; ++i) {
                const int r = lr + 32 * i;
                *(u32x4*)(Cs + r * LS + lc) = rC[i]; *(u32x4*)(Bs + r * LS + lc) = rB[i]; *(u32x4*)(BTs + r * LS + lc) = rBT[i];
            }
#pragma unroll
            for (int i = 0; i < 2; ++i) *(u32x4*)(XTs + (lr + 32 * i) * LS + lc) = rX[i];
            if (wid == 0) {
                const float d0 = rd0, d1 = rd1;
                const float v0 = d0 * A2, v1 = d1 * A2;
                float p0 = v0, p1 = v1;
#pragma unroll
                for (int o = 1; o < 64; o <<= 1) { const float a = __shfl_up(p0, o), bq = __shfl_up(p1, o); if (lane >= o) { p0 += a; p1 += bq; } }
                p1 += __shfl(p0, 63);
                const float total = __shfl(p1, 63);
                const float c0 = dir ? total - p0 + v0 : p0, c1 = dir ? total - p1 + v1 : p1;
                cum[lane] = c0; cum[64 + lane] = c1; dts[lane] = d0; dts[64 + lane] = d1;
                wj[lane] = d0 * __builtin_amdgcn_exp2f(total - c0); wj[64 + lane] = d1 * __builtin_amdgcn_exp2f(total - c1);
                if (lane == 0) misc[0] = total;
            }
            __syncthreads();
            if (step + 1 < 16) SSD_ISSUE(step + 1);
            const float ci = cum[irow];
            bf16x8 cf[4];
#pragma unroll
            for (int ns = 0; ns < 4; ++ns) cf[ns] = *(const bf16x8*)(Cs + irow * LS + ns * 32 + fq * 8);
            f32x4 yo[4];
#pragma unroll
            for (int i = 0; i < 4; ++i) yo[i] = (f32x4){0.f, 0.f, 0.f, 0.f};
#pragma unroll
            for (int ns = 0; ns < 4; ++ns)
#pragma unroll
                for (int pp = 0; pp < 4; ++pp) {
                    const bf16x8 a = *(const bf16x8*)(Hs + (pp * 16 + fr) * LS + ns * 32 + fq * 8);
                    yo[pp] = mfma16(a, cf[ns], yo[pp]);
                }
            {
                const float e = __builtin_amdgcn_exp2f(ci);
#pragma unroll
                for (int i = 0; i < 4; ++i) yo[i] *= e;
            }
#pragma unroll
            for (int js = 0; js < 4; ++js) {
                const bool need0 = dir ? (2 * js >= strip) : (2 * js <= strip), need1 = dir ? (2 * js + 1 >= strip) : (2 * js + 1 <= strip);
                if (need0 || need1) {
                    f32x4 g2[2];
#pragma unroll
                    for (int h = 0; h < 2; ++h) {
                        const int jt = js * 2 + h;
                        f32x4 g = {0.f, 0.f, 0.f, 0.f};
                        if (h == 0 ? need0 : need1) {
#pragma unroll
                            for (int ns = 0; ns < 4; ++ns) {
                                const bf16x8 a = *(const bf16x8*)(Bs + (jt * 16 + fr) * LS + ns * 32 + fq * 8);
                                g = mfma16(a, cf[ns], g);
                            }
                            const f32x4 cj = *(const f32x4*)(cum + jt * 16 + fq * 4), dj = *(const f32x4*)(dts + jt * 16 + fq * 4);
                            if (jt == strip) {
#pragma unroll
                                for (int e = 0; e < 4; ++e) {
                                    const int jj = jt * 16 + fq * 4 + e;
                                    const bool ok = dir ? (jj >= irow) : (jj <= irow);
                                    g[e] = ok ? g[e] * __builtin_amdgcn_exp2f(fminf(ci - cj[e], 0.f)) * dj[e] : 0.f;
                                }
                            } else {
#pragma unroll
                                for (int e = 0; e < 4; ++e) g[e] = g[e] * __builtin_amdgcn_exp2f(fminf(ci - cj[e], 0.f)) * dj[e];
                            }
                        }
                        g2[h] = g;
                    }
                    union { u32x4 u; bf16x8 v; } mb;
                    mb.u.x = pk2(g2[0][0], g2[0][1]); mb.u.y = pk2(g2[0][2], g2[0][3]);
                    mb.u.z = pk2(g2[1][0], g2[1][1]); mb.u.w = pk2(g2[1][2], g2[1][3]);
#pragma unroll
                    for (int pp = 0; pp < 4; ++pp) {
                        const bf16_t* xp = XTs + (pp * 16 + fr) * LS + js * 32 + fq * 4;
                        union { u32x4 u; bf16x8 v; } va;
                        const u32x2 lo = *(const u32x2*)xp, hi = *(const u32x2*)(xp + 16);
                        va.u.x = lo.x; va.u.y = lo.y; va.u.z = hi.x; va.u.w = hi.y;
                        yo[pp] = mfma16(va.v, mb.v, yo[pp]);
                    }
                }
            }
            if (dir == 0) {
                const float dsv = dsk[head] + dsk[32 + head];
#pragma unroll
                for (int pp = 0; pp < 4; ++pp)
#pragma unroll
                    for (int e = 0; e < 4; ++e) yo[pp][e] += dsv * bflo((unsigned)XTs[(pp * 16 + fq * 4 + e) * LS + irow]);
            }
#pragma unroll
            for (int pp = 0; pp < 4; ++pp) *(u32x2*)(Y + (size_t)(t0 + irow) * 2048 + head * 64 + pp * 16 + fq * 4) = pack4(yo[pp]);
            {
                const float dec = __builtin_amdgcn_exp2f(misc[0]);
#pragma unroll
                for (int k = 0; k < 4; ++k) hacc[k] *= dec;
#pragma unroll
                for (int js = 0; js < 4; ++js) {
                    const u32x4 xr = *(const u32x4*)(XTs + (pt * 16 + fr) * LS + js * 32 + fq * 8);
                    const f32x4 w0 = *(const f32x4*)(wj + js * 32 + fq * 8), w1 = *(const f32x4*)(wj + js * 32 + fq * 8 + 4);
                    union { u32x4 u; bf16x8 v; } xb;
                    xb.u.x = pk2(bflo(xr.x) * w0[0], bfhi(xr.x) * w0[1]); xb.u.y = pk2(bflo(xr.y) * w0[2], bfhi(xr.y) * w0[3]);
                    xb.u.z = pk2(bflo(xr.z) * w1[0], bfhi(xr.z) * w1[1]); xb.u.w = pk2(bflo(xr.w) * w1[2], bfhi(xr.w) * w1[3]);
#pragma unroll
                    for (int k = 0; k < 4; ++k) {
                        const bf16x8 a = *(const bf16x8*)(BTs + ((nt0 + k) * 16 + fr) * LS + js * 32 + fq * 8);
                        hacc[k] = mfma16(a, xb.v, hacc[k]);
                    }
                }
            }
            __syncthreads();
            if (last && !samp) {
#pragma unroll
                for (int k = 0; k < 4; ++k) *(f32x4*)(out_state + sbase + (nt0 + k) * 16) = hacc[k];
            }
        }
#undef SSD_DECODE
#undef SSD_ISSUE
    }
}

__device__ __forceinline__ void phase_gnorm(const bf16_t* __restrict__ YF, const bf16_t* __restrict__ YB, const bf16_t* __restrict__ XS, const bf16_t* __restrict__ ZXB, const float* __restrict__ dsk,
                            const float* __restrict__ ng, bf16_t* __restrict__ YN) {
    const int tid_ = tid_opaque(); const int lane = tid_ & 63, gw = bid_opaque() * 8 + (tid_ >> 6), nW = gridDim.x * 8;
#pragma unroll 2
    for (int tok = gw; tok < NTOK; tok += nW) {
        float v[4][8]; float ss = 0.f;
#pragma unroll
        for (int jj = 0; jj < 4; ++jj) {
            const int c = jj * 512 + lane * 8;
            const u32x4 yf = *(const u32x4*)(YF + (size_t)tok * 2048 + c), yb = *(const u32x4*)(YB + (size_t)tok * 2048 + c);
            const u32x4 z = *(const u32x4*)(ZXB + (size_t)tok * 5120 + c);
#pragma unroll
            for (int q = 0; q < 4; ++q) {
                const float y0 = bflo(yf[q]) + bflo(yb[q]), y1 = bfhi(yf[q]) + bfhi(yb[q]);
                const float g0 = y0 * silu_f(bflo(z[q])), g1 = y1 * silu_f(bfhi(z[q]));
                v[jj][2 * q] = g0; v[jj][2 * q + 1] = g1; ss += g0 * g0 + g1 * g1;
            }
        }
        const float r = rsqrtf(wave_sum(ss) * (1.f / 2048) + EPS);
#pragma unroll
        for (int jj = 0; jj < 4; ++jj) {
            const int c = jj * 512 + lane * 8;
            const f32x4 g0 = *(const f32x4*)(ng + c), g1 = *(const f32x4*)(ng + c + 4);
            u32x4 o;
            o.x = pk2(v[jj][0] * r * g0[0], v[jj][1] * r * g0[1]); o.y = pk2(v[jj][2] * r * g0[2], v[jj][3] * r * g0[3]);
            o.z = pk2(v[jj][4] * r * g1[0], v[jj][5] * r * g1[1]); o.w = pk2(v[jj][6] * r * g1[2], v[jj][7] * r * g1[3]);
            *(u32x4*)(YN + (size_t)tok * 2048 + c) = o;
        }
    }
}

#ifndef PHASE_MASK
#define PHASE_MASK 0xFFFF
#endif
#define EN(x) (((PHASE_MASK) >> (x)) & 1)
constexpr int N_PHASES = 50;

__device__ __forceinline__ void run_phase(const Params& p, int ph, unsigned char* smem) {
    size_t zoff = 0; asm volatile("" : "+s"(zoff));
    unsigned char* ws = p.ws + zoff;
    float* X = (float*)(ws + WS_X);
    bf16_t* H = (bf16_t*)(ws + WS_H);
    bf16_t* U = (bf16_t*)(ws + WS_U);
    if (ph == 0) { if (EN(0)) phase0(p, smem); return; }
    if (ph == N_PHASES - 1) { if (EN(2)) phase_final(X, p.in[25], p.out + OUT_Y); return; }
    const int layer = (ph - 1) / 12, s = (ph - 1) % 12, j = layer >> 1;
    const bool is_mla = (layer & 1) == 0;
    const float* modl = (const float*)(ws + WS_MOD) + (size_t)layer * 3 * NMODC;
    if (s == 0 || s == 3 || s == 9) {
        const int ni = s == 0 ? 0 : (s == 3 ? 1 : 2);
        if (EN(1)) phase_norm(X, p.in[8] + (size_t)(layer * 3 + ni) * D, modl, ni * 3, ni * 3 + 1, H);
        return;
    }
    if (s == 1 || s == 10) {
        const int f = s == 1 ? 0 : 1;
        Epi8SwiGLU e{U};
        pg8::StaticOrder so; so.init(NTOK, 5632, gridDim.x, bid_opaque());
        if (EN(3)) pg8::gemm_phase((PG8_LAS unsigned char*)smem, H, (const bf16_t*)(ws + WS_W1T) + (size_t)(layer * 2 + f) * 5632 * 1024, 1024, so, e);
        return;
    }
    if (s == 2 || s == 11 || s == 8) {
        const bf16_t* A; const bf16_t* Bt; int K; int chunk; float sc;
        if (s == 2 || s == 11) { const int f = s == 2 ? 0 : 1; A = U; K = DFF; Bt = (const bf16_t*)(ws + WS_W2T) + (size_t)(layer * 2 + f) * 1024 * 2816; chunk = s == 2 ? 2 : 8; sc = 0.5f; }
        else if (is_mla) { A = (const bf16_t*)(ws + WS_O); K = 1024; Bt = (const bf16_t*)(ws + WS_MWO) + (size_t)j * 1024 * 1024; chunk = 5; sc = 1.f; }
        else { A = (const bf16_t*)(ws + WS_YN); K = 2048; Bt = (const bf16_t*)(ws + WS_SWOUT) + (size_t)j * 1024 * 2048; chunk = 5; sc = 1.f; }
        EpiResid e{X, modl + chunk * 1024, sc};
        if (EN(4)) gemm_tiles(A, K, Bt, K, NTOK, 1024, K, e, smem, 0);
        return;
    }
    if (is_mla) {
        if (s == 4) {
            EpiF32 e{(float*)(ws + WS_QKVA), 800, 800};
            if (EN(5)) gemm_tiles(H, D, (const bf16_t*)(ws + WS_MWIN) + (size_t)j * MLA_NPAD * 1024, 1024, NTOK, MLA_NPAD, 1024, e, smem, 0);
        } else if (s == 5) {
            if (EN(6)) phase_mlanorm((const float*)(ws + WS_QKVA), p.in[12] + j * 512, p.in[13] + j * 256, p.in[2], j, (const float*)(ws + WS_ROPE),
                          (bf16_t*)(ws + WS_QA), (bf16_t*)(ws + WS_CKV), (bf16_t*)(ws + WS_KR), p.out + OUT_CACHE);
        } else if (s == 6) {
            EpiQ eq{(bf16_t*)(ws + WS_Q), (const float*)(ws + WS_ROPE), 0.14724444f  };
            if (EN(7)) gemm_tiles((const bf16_t*)(ws + WS_QA), 512, (const bf16_t*)(ws + WS_MWQB) + (size_t)j * 1536 * 512, 512, NTOK, 1536, 512, eq, smem, 0);
            {
                EpiBf16 e{(bf16_t*)(ws + WS_KN), 1024};
                if (EN(7)) gemm_tiles((const bf16_t*)(ws + WS_CKV), 256, (const bf16_t*)(ws + WS_MWKN) + (size_t)j * 1024 * 256, 256, NTOKKV, 1024, 256, e, smem, 128);
            }
            {
                EpiBf16T e{(bf16_t*)(ws + WS_VT), NTOKKV};
                if (EN(7)) gemm_tiles((const bf16_t*)(ws + WS_MWV) + (size_t)j * 1024 * 256, 256, (const bf16_t*)(ws + WS_CKV), 256, 1024, NTOKKV, 256, e, smem, 144);
            }
        } else if (s == 7) {
            if (EN(8)) phase_attn((const bf16_t*)(ws + WS_Q), (const bf16_t*)(ws + WS_KN), (const bf16_t*)(ws + WS_KR), (const bf16_t*)(ws + WS_VT), (bf16_t*)(ws + WS_O), smem);
        }
    } else {
        if (s == 4) {
            Epi8SSMIn e{(bf16_t*)(ws + WS_ZXB), (float*)(ws + WS_DTRAW)};
            pg8::StaticOrder so; so.init(NTOK, SSM_NPAD, gridDim.x, bid_opaque());
            if (EN(9)) pg8::gemm_phase((PG8_LAS unsigned char*)smem, H, (const bf16_t*)(ws + WS_SWIN) + (size_t)j * SSM_NPAD * 1024, 1024, so, e);
        } else if (s == 5) {
            if (EN(10)) phase_conv((const bf16_t*)(ws + WS_ZXB), (const float*)(ws + WS_DTRAW), p.in[18] + (size_t)j * 5 * 3072, p.in[19] + j * 3072, p.in[20] + j * 64,
                       (bf16_t*)(ws + WS_XS), (bf16_t*)(ws + WS_XT), (bf16_t*)(ws + WS_BM), (bf16_t*)(ws + WS_BT), (bf16_t*)(ws + WS_CM), (float*)(ws + WS_DT), smem);
        } else if (s == 6) {
            if (EN(11)) phase_ssd((const bf16_t*)(ws + WS_XT), (const bf16_t*)(ws + WS_BM), (const bf16_t*)(ws + WS_BT), (const bf16_t*)(ws + WS_CM), (const float*)(ws + WS_DT),
                      p.in[21] + j * 64, p.in[3], j, (bf16_t*)(ws + WS_YF), (bf16_t*)(ws + WS_YB), p.out + OUT_STATE, smem, p.in[22] + j * 64);
        } else if (s == 7) {
            if (EN(12)) phase_gnorm((const bf16_t*)(ws + WS_YF), (const bf16_t*)(ws + WS_YB), (const bf16_t*)(ws + WS_XS), (const bf16_t*)(ws + WS_ZXB), p.in[22] + j * 64, p.in[23] + j * 2048,
                        (bf16_t*)(ws + WS_YN));
        }
    }
}

#define XB_TMO      128
#define XB_XCNT(j)  (256  + 64 * (j))
#define XB_XSUB(j)  (1280 + 64 * (j))
#define XB_XGEN(j)  (2304 + 64 * (j))
#define XB_TOP      3328
#define XB_TOPGEN   3392
#define XCD_BAR_WORDS 3456
#define XB_SPIN_CAP (1u << 18)
#define LAS __attribute__((address_space(3)))

__device__ __forceinline__ unsigned xb_ld(unsigned* p)              { return __hip_atomic_load(p, __ATOMIC_RELAXED, __HIP_MEMORY_SCOPE_AGENT); }
__device__ __forceinline__ unsigned xb_add(unsigned* p, unsigned v) { return __hip_atomic_fetch_add(p, v, __ATOMIC_RELAXED, __HIP_MEMORY_SCOPE_AGENT); }
__device__ __forceinline__ unsigned xb_xcc_id() { return (unsigned)__builtin_amdgcn_s_getreg((3 << 11) | 20) & 0xFu; }
#define XB_SPIN(cond, bar) do { unsigned _sp = 0; while (cond) { __builtin_amdgcn_s_sleep(1); \
    if ((++_sp & 255u) == 0u) { if (xb_ld(&(bar)[XB_TMO])) break; if (_sp > XB_SPIN_CAP) { atomicAdd(&(bar)[XB_TMO], 1u); break; } } } } while (0)

struct XcdBarrier {
    unsigned* bar; unsigned x;
    volatile LAS unsigned* st;
};

__device__ __forceinline__ XcdBarrier xcd_barrier_post(unsigned* bar, volatile LAS unsigned* st) {
    XcdBarrier b; b.bar = bar; b.x = xb_xcc_id(); b.st = st;
    if (threadIdx.x == 0) (void)xb_add(&bar[XB_XCNT(b.x)], 1u);
    return b;
}
__device__ __forceinline__ void xcd_barrier_complete(unsigned* bar, unsigned x, unsigned& nloc, unsigned& nx) {
    const unsigned G = gridDim.x * gridDim.y * gridDim.z;
    unsigned sum, cnt, mine, sp = 0u;
    for (;;) {
        sum = 0u; cnt = 0u; mine = 0u;
#pragma unroll
        for (unsigned j = 0; j < 16; ++j) { const unsigned c = xb_ld(&bar[XB_XCNT(j)]); sum += c; cnt += (c > 0u) ? 1u : 0u; mine = (j == x) ? c : mine; }
        if (sum == G) break;
        __builtin_amdgcn_s_sleep(1);
        if ((++sp & 255u) == 0u) { if (xb_ld(&bar[XB_TMO])) break; if (sp > XB_SPIN_CAP) { atomicAdd(&bar[XB_TMO], 1u); break; } }
    }
    nloc = mine > 0u ? mine : 1u; nx = cnt > 0u ? cnt : 1u;
}

__device__ __forceinline__ void xcd_barrier(const XcdBarrier& b) {
    asm volatile("s_waitcnt vmcnt(0)" ::: "memory");
    __syncthreads();
    if (threadIdx.x == 0) {
        unsigned* bar = b.bar;
        __builtin_amdgcn_s_waitcnt(0);
        unsigned nloc = b.st[0], nx = b.st[1];
        if (nloc == 0u) { xcd_barrier_complete(bar, b.x, nloc, nx); b.st[0] = nloc; b.st[1] = nx; }
        const unsigned old = xb_add(&bar[XB_XSUB(b.x)], 1u);
        const unsigned gen = old / nloc;
        if (old + 1u == (gen + 1u) * nloc) {
            __builtin_amdgcn_fence(__ATOMIC_RELEASE, "agent");
            asm volatile("s_waitcnt vmcnt(0)" ::: "memory");
            const unsigned og = xb_add(&bar[XB_TOP], 1u);
            const unsigned tg = og / nx;
            if (og + 1u == (tg + 1u) * nx) xb_add(&bar[XB_TOPGEN], 1u);
            else XB_SPIN(xb_ld(&bar[XB_TOPGEN]) == tg, bar);
            __builtin_amdgcn_fence(__ATOMIC_ACQUIRE, "agent");
            xb_add(&bar[XB_XGEN(b.x)], 1u);
            asm volatile("s_waitcnt vmcnt(0)" ::: "memory");
        } else {
            XB_SPIN(xb_ld(&bar[XB_XGEN(b.x)]) == gen, bar);
            __builtin_amdgcn_fence(__ATOMIC_ACQUIRE, "agent");
            asm volatile("s_waitcnt vmcnt(0)" ::: "memory");
        }
    }
    __syncthreads();
}

__device__ __forceinline__ void grid_barrier(unsigned* ctr, unsigned target) {
    __syncthreads();
    if (threadIdx.x == 0) {
        __threadfence();
        __hip_atomic_fetch_add(ctr, 1u, __ATOMIC_RELAXED, __HIP_MEMORY_SCOPE_AGENT);
        while (__hip_atomic_load(ctr, __ATOMIC_RELAXED, __HIP_MEMORY_SCOPE_AGENT) < target) __builtin_amdgcn_s_sleep(1);
        __threadfence();
    }
    __syncthreads();
}

__global__ void __launch_bounds__(NT) mega_fwd(Params p) {
    extern __shared__ __attribute__((aligned(16))) unsigned char smem[];
    cg::grid_group grid = cg::this_grid();
    volatile LAS unsigned* xst = (volatile LAS unsigned*)(smem + LDS_BYTES - 16);
    if (threadIdx.x == 0) { xst[0] = 0u; xst[1] = 0u; }
    __syncthreads();
    XcdBarrier xb = xcd_barrier_post((unsigned*)(p.ws + WS_BAR), xst);
    for (int ph = p.ph_lo; ph < p.ph_hi; ++ph) {
        if (ph > p.ph_lo) { if (ph == 1) grid.sync(); else xcd_barrier(xb); }
        run_phase(p, ph, smem);
    }
}

extern "C" void kernel_launch(void* const* d_in, const int* in_sizes, int n_in, void* d_out, int out_size, void* d_ws, size_t ws_size, hipStream_t stream) {
    static int grid_blocks = 0;
    if (grid_blocks == 0) {
        if (n_in != 26 || ws_size < WS_END) { fprintf(stderr, "kernel_launch: unexpected n_in %d / ws_size %zu (need %zu)\n", n_in, ws_size, (size_t)WS_END); grid_blocks = -1; return; }
        int dev = 0, cus = 0, per_cu = 0;
        (void)hipGetDevice(&dev);
        (void)hipDeviceGetAttribute(&cus, hipDeviceAttributeMultiprocessorCount, dev);
        if (hipFuncSetAttribute((const void*)mega_fwd, hipFuncAttributeMaxDynamicSharedMemorySize, LDS_BYTES) != hipSuccess) { fprintf(stderr, "kernel_launch: hipFuncSetAttribute failed\n"); }
        if (hipOccupancyMaxActiveBlocksPerMultiprocessor(&per_cu, (const void*)mega_fwd, NT, LDS_BYTES) != hipSuccess || per_cu < 1) { fprintf(stderr, "kernel_launch: occupancy query says %d\n", per_cu); per_cu = 1; }
        (void)hipGetLastError();
        grid_blocks = cus * 1;
        if (grid_blocks <= 0) grid_blocks = 256;
    }
    if (grid_blocks < 0) return;
    Params p;
    memset(&p, 0, sizeof(p));
    for (int i = 0; i < 26; ++i) p.in[i] = (const float*)d_in[i];
    p.out = (float*)d_out; p.ws = (unsigned char*)d_ws;
#if N_LAUNCH_MODE == 1
    (void)hipMemsetAsync((unsigned char*)d_ws + WS_BAR, 0, 16384, stream);
    p.ph_lo = 0; p.ph_hi = N_PHASES;
    void* args[] = {&p};
    hipError_t e = hipLaunchCooperativeKernel((const void*)mega_fwd, dim3(grid_blocks), dim3(NT), args, LDS_BYTES, stream);
    if (e != hipSuccess) fprintf(stderr, "cooperative launch failed: %s (grid %d)\n", hipGetErrorString(e), grid_blocks);
#else
    for (int ph = 0; ph < N_PHASES; ++ph) {
#ifdef PH_LIMIT
        if (ph >= PH_LIMIT && ph != N_PHASES - 1) continue;
#endif
        p.ph_lo = ph; p.ph_hi = ph + 1;
        hipLaunchKernelGGL(mega_fwd, dim3(grid_blocks), dim3(NT), LDS_BYTES, stream, p);
    }
#endif
}
```

```cpp
#include <hip/hip_runtime.h>
#include <hip/hip_cooperative_groups.h>
#include <cstdio>
#include <cstring>
namespace cg = cooperative_groups;

#ifndef N_LAUNCH_MODE
#define N_LAUNCH_MODE 1
#endif

typedef unsigned short bf16_t;
typedef short bf16x8 __attribute__((ext_vector_type(8)));
typedef float f32x4 __attribute__((ext_vector_type(4)));
typedef unsigned u32x2 __attribute__((ext_vector_type(2)));
typedef unsigned u32x4 __attribute__((ext_vector_type(4)));

constexpr int NT = 512;
constexpr int NTOK = 8192;
constexpr int NTOKKV = 8704;
constexpr int D = 1024, DFF = 2816, NMODC = 9216;
constexpr int SSM_NPAD = 5376;
constexpr int MLA_NPAD = 896;
constexpr float EPS = 1e-6f;

constexpr size_t al256(size_t x) { return (x + 255) & ~(size_t)255; }
constexpr size_t WS_X = 0;
constexpr size_t WS_H = WS_X + al256((size_t)NTOK * D * 4);
constexpr size_t WS_U = WS_H + al256((size_t)NTOK * D * 2);
constexpr size_t WS_MOD = WS_U + al256((size_t)NTOK * DFF * 2);
constexpr size_t WS_ROPE = WS_MOD + al256((size_t)4 * 3 * NMODC * 4);
constexpr size_t WS_W1T = WS_ROPE + al256((size_t)2048 * 32 * 4);
constexpr size_t WS_W2T = WS_W1T + al256((size_t)8 * 5632 * 1024 * 2);
constexpr size_t WS_MWIN = WS_W2T + al256((size_t)8 * 1024 * 2816 * 2);
constexpr size_t WS_MWQB = WS_MWIN + al256((size_t)2 * MLA_NPAD * 1024 * 2);
constexpr size_t WS_MWKN = WS_MWQB + al256((size_t)2 * 1536 * 512 * 2);
constexpr size_t WS_MWV = WS_MWKN + al256((size_t)2 * 1024 * 256 * 2);
constexpr size_t WS_MWO = WS_MWV + al256((size_t)2 * 1024 * 256 * 2);
constexpr size_t WS_SWIN = WS_MWO + al256((size_t)2 * 1024 * 1024 * 2);
constexpr size_t WS_SWOUT = WS_SWIN + al256((size_t)2 * SSM_NPAD * 1024 * 2);
constexpr size_t WS_TMP = WS_SWOUT + al256((size_t)2 * 1024 * 2048 * 2);
constexpr size_t WS_QKVA = WS_TMP;
constexpr size_t WS_QA = WS_QKVA + al256((size_t)NTOK * 800 * 4);
constexpr size_t WS_CKV = WS_QA + al256((size_t)NTOK * 512 * 2);
constexpr size_t WS_KR = WS_CKV + al256((size_t)NTOKKV * 256 * 2);
constexpr size_t WS_Q = WS_KR + al256((size_t)NTOKKV * 32 * 2);
constexpr size_t WS_KN = WS_Q + al256((size_t)NTOK * 1536 * 2);
constexpr size_t WS_VT = WS_KN + al256((size_t)NTOKKV * 1024 * 2);
constexpr size_t WS_O = WS_VT + al256((size_t)1024 * NTOKKV * 2);
constexpr size_t WS_MLA_END = WS_O + al256((size_t)NTOK * 1024 * 2);
constexpr size_t WS_ZXB = WS_TMP;
constexpr size_t WS_DTRAW = WS_ZXB + al256((size_t)NTOK * 5120 * 2);
constexpr size_t WS_XS = WS_DTRAW + al256((size_t)NTOK * 64 * 4);
constexpr size_t WS_XT = WS_XS + al256((size_t)NTOK * 2048 * 2);
constexpr size_t WS_BM = WS_XT + al256((size_t)NTOK * 2048 * 2);
constexpr size_t WS_BT = WS_BM + al256((size_t)NTOK * 512 * 2);
constexpr size_t WS_CM = WS_BT + al256((size_t)NTOK * 512 * 2);
constexpr size_t WS_DT = WS_CM + al256((size_t)NTOK * 512 * 2);
constexpr size_t WS_YF = WS_DT + al256((size_t)NTOK * 64 * 4);
constexpr size_t WS_YB = WS_YF + al256((size_t)NTOK * 2048 * 2);
constexpr size_t WS_YN = WS_YB + al256((size_t)NTOK * 2048 * 2);
constexpr size_t WS_SSM_END = WS_YN + al256((size_t)NTOK * 2048 * 2);
constexpr size_t WS_BAR = WS_SSM_END > WS_MLA_END ? WS_SSM_END : WS_MLA_END;
constexpr size_t WS_END = WS_BAR + 16384;

constexpr size_t OUT_Y = 0;
constexpr size_t OUT_CACHE = (size_t)NTOK * D;
constexpr size_t OUT_STATE = OUT_CACHE + (size_t)16 * 2 * 256 * 288;

constexpr int LDS_BYTES = 141312;

struct Params {
    const float* in[26];
    float* out;
    unsigned char* ws;
    int ph_lo, ph_hi;
};

typedef __bf16 bf16v2_t __attribute__((ext_vector_type(2)));
typedef float f32v2_t __attribute__((ext_vector_type(2)));
__device__ __forceinline__ unsigned pk2(float lo, float hi) { f32v2_t f = {lo, hi}; bf16v2_t b = __builtin_convertvector(f, bf16v2_t); return __builtin_bit_cast(unsigned, b); }
__device__ __forceinline__ bf16_t f2bf(float f) { return (bf16_t)(pk2(f, 0.f) & 0xffffu); }
__device__ __forceinline__ float bflo(unsigned u) { return __uint_as_float(u << 16); }
__device__ __forceinline__ float bfhi(unsigned u) { return __uint_as_float(u & 0xffff0000u); }
__device__ __forceinline__ float silu_f(float x) { return x / (1.f + __expf(-x)); }
__device__ __forceinline__ float wave_sum(float v) {
#pragma unroll
    for (int o = 32; o > 0; o >>= 1) v += __shfl_xor(v, o);
    return v;
}
__device__ __forceinline__ u32x2 pack4(f32x4 v) { u32x2 r; r.x = pk2(v[0], v[1]); r.y = pk2(v[2], v[3]); return r; }
__device__ __forceinline__ f32x4 mfma16(bf16x8 a, bf16x8 b, f32x4 c) { return __builtin_amdgcn_mfma_f32_16x16x32_bf16(a, b, c, 0, 0, 0); }
__device__ __forceinline__ int modrow(int tok) { return tok < 4096 ? 0 : 1 + ((tok - 4096) >> 11); }

__device__ __forceinline__ int tid_opaque() { int t = threadIdx.x; asm volatile("" : "+v"(t)); return t; }
__device__ __forceinline__ int bid_opaque() { int t = blockIdx.x; asm volatile("" : "+s"(t)); return t; }
__device__ __forceinline__ void conv_tile(const float* __restrict__ src, int ldsrc, int nvalid, int mode, bf16_t* __restrict__ dst, int K, int n0, int k0, bf16_t* tile) {
    const int tid = tid_opaque();
    {
        const int nn = tid & 63, kr = tid >> 6, n = n0 + nn;
        int col; bool valid = true;
        if (mode == 0) { col = n; valid = n < nvalid; }
        else if (mode == 1) { const int q = n >> 8, w = n & 255; col = (w < 128) ? (q * 128 + w) : (DFF + q * 128 + (w - 128)); }
        else if (mode == 2) { col = (n >> 6) * 128 + (n & 63); }
        else { col = (n >> 6) * 128 + 64 + (n & 63); }
        const float* s = src + (size_t)(k0 + kr) * ldsrc + col;
#pragma unroll
        for (int ps = 0; ps < 8; ++ps) {
            const float v = valid ? __builtin_nontemporal_load(s + (size_t)(ps * 8) * ldsrc) : 0.f;
            tile[nn * 66 + ps * 8 + kr] = f2bf(v);
        }
    }
    __syncthreads();
    {
        const int nn = tid >> 3, ch = tid & 7;
        const unsigned* t32 = (const unsigned*)tile + nn * 33 + ch * 4;
        u32x4 o; o.x = t32[0]; o.y = t32[1]; o.z = t32[2]; o.w = t32[3];
        *(u32x4*)(dst + (size_t)(n0 + nn) * K + k0 + ch * 8) = o;
    }
    __syncthreads();
}

__device__ __forceinline__ void phase0(const Params& p, unsigned char* smem) {
    const int tid = tid_opaque(), G = gridDim.x, b = bid_opaque();
    float* X = (float*)(p.ws + WS_X);
    {
        float* rope = (float*)(p.ws + WS_ROPE);
        for (int i = b * NT + tid; i < 2048 * 16; i += G * NT) {
            const int pos = i >> 4, a = (i >> 3) & 1, f = i & 7;
            const double position = a == 0 ? (double)(pos >> 6) : (double)(pos & 63);
            double freq = (f & 1) ? 0.31622776601683794 : 1.0;
            const int f2 = f >> 1; if (f2 == 1) freq *= 0.1; else if (f2 == 2) freq *= 0.01; else if (f2 == 3) freq *= 0.001;
            const double ang = position * freq;
            const double kq = rint(ang * 0.63661977236758134);
            const double r = ang - kq * 1.5707963267948966;
            const double r2 = r * r;
            double sn = r * (1.0 + r2 * (-1.0 / 6 + r2 * (1.0 / 120 + r2 * (-1.0 / 5040 + r2 * (1.0 / 362880 + r2 * (-1.0 / 39916800 + r2 * (1.0 / 6227020800.0 + r2 * (-1.0 / 1307674368000.0))))))));
            double cs = 1.0 + r2 * (-0.5 + r2 * (1.0 / 24 + r2 * (-1.0 / 720 + r2 * (1.0 / 40320 + r2 * (-1.0 / 3628800 + r2 * (1.0 / 479001600.0 + r2 * (-1.0 / 87178291200.0 + r2 * (1.0 / 20922789888000.0))))))));
            const int q = ((int)kq) & 3;
            double c, s;
            if (q == 0) { c = cs; s = sn; } else if (q == 1) { c = -sn; s = cs; } else if (q == 2) { c = -cs; s = -sn; } else { c = sn; s = -cs; }
            rope[pos * 32 + a * 8 + f] = (float)c;
            rope[pos * 32 + 16 + a * 8 + f] = (float)s;
        }
    }
    {
        float* sc = (float*)smem; float* red = sc + 3072;
        const float* cin = p.in[4]; const float* cctx = p.in[5];
        for (int i = tid; i < 3072; i += NT) { const int row = i >> 10, k = i & 1023; const float c = row == 0 ? cctx[k] : cin[(row - 1) * 1024 + k]; sc[i] = silu_f(c); }
        __syncthreads();
        float* MOD = (float*)(p.ws + WS_MOD);
        for (int item = b; item < 4 * 288; item += G) {
            const int layer = item / 288, col0 = (item % 288) * 32;
            const int cq = tid & 7, ks = tid >> 3;
            const float* w = p.in[6] + (size_t)layer * 1024 * NMODC + (size_t)(ks * 16) * NMODC + col0 + cq * 4;
            f32x4 a0 = {0.f, 0.f, 0.f, 0.f}, a1 = a0, a2 = a0;
            f32x4 wv[16];
#pragma unroll
            for (int kk = 0; kk < 16; ++kk) wv[kk] = __builtin_nontemporal_load((const f32x4*)(w + (size_t)kk * NMODC));
            asm volatile("" ::: "memory");
#pragma unroll
            for (int kk = 0; kk < 16; ++kk) {
                const int k = ks * 16 + kk;
                a0 += sc[k] * wv[kk]; a1 += sc[1024 + k] * wv[kk]; a2 += sc[2048 + k] * wv[kk];
            }
            *(f32x4*)(red + ks * 96 + cq * 4) = a0; *(f32x4*)(red + ks * 96 + 32 + cq * 4) = a1; *(f32x4*)(red + ks * 96 + 64 + cq * 4) = a2;
            __syncthreads();
            if (tid < 96) {
                float s = 0.f;
                for (int k2 = 0; k2 < 64; ++k2) s += red[k2 * 96 + tid];
                const int row = tid >> 5, c = tid & 31;
                MOD[(size_t)(layer * 3 + row) * NMODC + col0 + c] = s + p.in[7][(size_t)layer * NMODC + col0 + c];
            }
            __syncthreads();
        }
    }
    {
        bf16_t* tile = (bf16_t*)smem;
        constexpr int T_W1 = 88 * 16, T_W2 = 16 * 44, T_MIN = 14 * 16, T_MQB = 24 * 8, T_MKV = 16 * 4, T_MO = 16 * 16, T_SIN = 84 * 16, T_SOUT = 16 * 32;
        constexpr int TOTAL = 8 * T_W1 + 8 * T_W2 + 2 * (T_MIN + T_MQB + 2 * T_MKV + T_MO) + 2 * (T_SIN + T_SOUT);
        const int nn = tid & 63, kr = tid >> 6, on = tid >> 3, och = tid & 7;
        for (int t0 = b; t0 < TOTAL; t0 += 4 * G) {
            float v[4][8];
            bf16_t* dsts[4];
#pragma unroll
            for (int u = 0; u < 4; ++u) {
                int r = t0 + u * G;
                const bool live = r < TOTAL;
                if (!live) r = 0;
                const float* src; bf16_t* dst; int K, ld, nvalid, mode;
                if (r < 8 * T_W1) { const int j = r / T_W1; r -= j * T_W1; src = p.in[9] + (size_t)j * 1024 * 5632; dst = (bf16_t*)(p.ws + WS_W1T) + (size_t)j * 5632 * 1024; K = 1024; ld = 5632; nvalid = 5632; mode = 1; }
                else if ((r -= 8 * T_W1) < 8 * T_W2) { const int j = r / T_W2; r -= j * T_W2; src = p.in[10] + (size_t)j * 2816 * 1024; dst = (bf16_t*)(p.ws + WS_W2T) + (size_t)j * 1024 * 2816; K = 2816; ld = 1024; nvalid = 1024; mode = 0; }
                else if ((r -= 8 * T_W2) < 2 * T_MIN) { const int j = r / T_MIN; r -= j * T_MIN; src = p.in[11] + (size_t)j * 1024 * 800; dst = (bf16_t*)(p.ws + WS_MWIN) + (size_t)j * MLA_NPAD * 1024; K = 1024; ld = 800; nvalid = 800; mode = 0; }
                else if ((r -= 2 * T_MIN) < 2 * T_MQB) { const int j = r / T_MQB; r -= j * T_MQB; src = p.in[14] + (size_t)j * 512 * 1536; dst = (bf16_t*)(p.ws + WS_MWQB) + (size_t)j * 1536 * 512; K = 512; ld = 1536; nvalid = 1536; mode = 0; }
                else if ((r -= 2 * T_MQB) < 2 * T_MKV) { const int j = r / T_MKV; r -= j * T_MKV; src = p.in[15] + (size_t)j * 256 * 2048; dst = (bf16_t*)(p.ws + WS_MWKN) + (size_t)j * 1024 * 256; K = 256; ld = 2048; nvalid = 1024; mode = 2; }
                else if ((r -= 2 * T_MKV) < 2 * T_MKV) { const int j = r / T_MKV; r -= j * T_MKV; src = p.in[15] + (size_t)j * 256 * 2048; dst = (bf16_t*)(p.ws + WS_MWV) + (size_t)j * 1024 * 256; K = 256; ld = 2048; nvalid = 1024; mode = 3; }
                else if ((r -= 2 * T_MKV) < 2 * T_MO) { const int j = r / T_MO; r -= j * T_MO; src = p.in[16] + (size_t)j * 1024 * 1024; dst = (bf16_t*)(p.ws + WS_MWO) + (size_t)j * 1024 * 1024; K = 1024; ld = 1024; nvalid = 1024; mode = 0; }
                else if ((r -= 2 * T_MO) < 2 * T_SIN) { const int j = r / T_SIN; r -= j * T_SIN; src = p.in[17] + (size_t)j * 1024 * 5184; dst = (bf16_t*)(p.ws + WS_SWIN) + (size_t)j * SSM_NPAD * 1024; K = 1024; ld = 5184; nvalid = 5184; mode = 0; }
                else { r -= 2 * T_SIN; const int j = r / T_SOUT; r -= j * T_SOUT; src = p.in[24] + (size_t)j * 2048 * 1024; dst = (bf16_t*)(p.ws + WS_SWOUT) + (size_t)j * 1024 * 2048; K = 2048; ld = 1024; nvalid = 1024; mode = 0; }
                const int nkt = K >> 6, n0 = (r / nkt) * 64, k0 = (r % nkt) * 64, n = n0 + nn;
                int col; bool valid = live;
                if (mode == 0) { col = n; valid = valid && n < nvalid; }
                else if (mode == 1) { const int q = n >> 8, w = n & 255; col = (w < 128) ? (q * 128 + w) : (DFF + q * 128 + (w - 128)); }
                else if (mode == 2) { col = (n >> 6) * 128 + (n & 63); }
                else { col = (n >> 6) * 128 + 64 + (n & 63); }
                const float* sp = src + (size_t)(k0 + kr) * ld + (valid ? col : 0);
#pragma unroll
                for (int ps = 0; ps < 8; ++ps) { const float x = __builtin_nontemporal_load(sp + (size_t)(ps * 8) * ld); v[u][ps] = valid ? x : 0.f; }
                dsts[u] = live ? dst + (size_t)(n0 + on) * K + k0 + och * 8 : nullptr;
            }
#pragma unroll
            for (int u = 0; u < 4; ++u)
#pragma unroll
                for (int ps = 0; ps < 8; ++ps) tile[u * 4224 + nn * 66 + ps * 8 + kr] = f2bf(v[u][ps]);
            __syncthreads();
#pragma unroll
            for (int u = 0; u < 4; ++u) {
                const unsigned* t32 = (const unsigned*)(tile + u * 4224) + on * 33 + och * 4;
                u32x4 o; o.x = t32[0]; o.y = t32[1]; o.z = t32[2]; o.w = t32[3];
                if (dsts[u]) *(u32x4*)dsts[u] = o;
            }
            __syncthreads();
        }
    }
}

__device__ __forceinline__ void phase_norm(const float* __restrict__ Xlo, const float* __restrict__ Xhi, int hioff, const float* __restrict__ g, const float* __restrict__ modl, int shift_chunk, int scale_chunk, bf16_t* __restrict__ H) {
    const int tid_ = tid_opaque(); const int lane = tid_ & 63, gw = bid_opaque() * 8 + (tid_ >> 6), nW = gridDim.x * 8;
#pragma unroll 4
    for (int tok = gw; tok < NTOK; tok += nW) {
        const float* xr = (tok < 4096 ? Xlo + (size_t)tok * D : Xhi + (size_t)(tok - hioff) * D) + lane * 4;
        f32x4 v[4]; float ss = 0.f;
#pragma unroll
        for (int j = 0; j < 4; ++j) { v[j] = *(const f32x4*)(xr + 256 * j); ss += v[j][0] * v[j][0] + v[j][1] * v[j][1] + v[j][2] * v[j][2] + v[j][3] * v[j][3]; }
        const float r = rsqrtf(wave_sum(ss) * (1.f / D) + EPS);
        const float* mr = modl + (size_t)modrow(tok) * NMODC;
#pragma unroll
        for (int j = 0; j < 4; ++j) {
            const int k = lane * 4 + 256 * j;
            const f32x4 gv = *(const f32x4*)(g + k), sc = *(const f32x4*)(mr + scale_chunk * 1024 + k), sh = *(const f32x4*)(mr + shift_chunk * 1024 + k);
            f32x4 h;
#pragma unroll
            for (int e = 0; e < 4; ++e) h[e] = v[j][e] * r * gv[e] * (1.f + sc[e]) + sh[e];
            *(u32x2*)(H + (size_t)tok * D + k) = pack4(h);
        }
    }
}
__device__ __forceinline__ void phase_final(const float* __restrict__ X, const float* __restrict__ g, float* __restrict__ out) {
    const int tid_ = tid_opaque(); const int lane = tid_ & 63, gw = bid_opaque() * 8 + (tid_ >> 6), nW = gridDim.x * 8;
#pragma unroll 4
    for (int tok = gw; tok < NTOK; tok += nW) {
        const float* xr = X + (size_t)tok * D + lane * 4;
        f32x4 v[4]; float ss = 0.f;
#pragma unroll
        for (int j = 0; j < 4; ++j) { v[j] = *(const f32x4*)(xr + 256 * j); ss += v[j][0] * v[j][0] + v[j][1] * v[j][1] + v[j][2] * v[j][2] + v[j][3] * v[j][3]; }
        const float r = rsqrtf(wave_sum(ss) * (1.f / D) + EPS);
#pragma unroll
        for (int j = 0; j < 4; ++j) {
            const int k = lane * 4 + 256 * j;
            const f32x4 gv = *(const f32x4*)(g + k);
            f32x4 h;
#pragma unroll
            for (int e = 0; e < 4; ++e) h[e] = v[j][e] * r * gv[e];
            *(f32x4*)(out + (size_t)tok * D + k) = h;
        }
    }
}

struct EpiSwiGLU {
    bf16_t* U;
    __device__ __forceinline__ void operator()(f32x4 (&acc)[4][4], int row0, int col0, int fr, int fq) const {
        const int j0 = (col0 >> 6) * 32;
#pragma unroll
        for (int mt = 0; mt < 4; ++mt) {
            const int row = row0 + mt * 16 + fr;
#pragma unroll
            for (int h = 0; h < 2; ++h) {
                f32x4 o;
#pragma unroll
                for (int e = 0; e < 4; ++e) o[e] = silu_f(acc[mt][h][e]) * acc[mt][h + 2][e];
                *(u32x2*)(U + (size_t)row * DFF + j0 + h * 16 + fq * 4) = pack4(o);
            }
        }
    }
};
struct EpiResid {
    float* X; const float* gate; float s;
    const float* Rlo; const float* Rhi; int hioff;
    __device__ __forceinline__ void operator()(f32x4 (&acc)[4][4], int row0, int col0, int fr, int fq) const {
        const float* gr = gate + (size_t)modrow(row0) * NMODC + col0 + fq * 4;
        float* xp0 = X + (size_t)(row0 + fr) * D + col0 + fq * 4;
        const float* xr0 = (row0 < 4096 ? Rlo + (size_t)(row0 + fr) * D : Rhi + (size_t)(row0 + fr - hioff) * D) + col0 + fq * 4;
        f32x4 gv[4], x[4][4];
#pragma unroll
        for (int nt = 0; nt < 4; ++nt) gv[nt] = *(const f32x4*)(gr + nt * 16);
#pragma unroll
        for (int mt = 0; mt < 4; ++mt)
#pragma unroll
            for (int nt = 0; nt < 4; ++nt) x[mt][nt] = *(const f32x4*)(xr0 + (size_t)(mt * 16) * D + nt * 16);
        asm volatile("" ::: "memory");
#pragma unroll
        for (int mt = 0; mt < 4; ++mt)
#pragma unroll
            for (int nt = 0; nt < 4; ++nt) {
#pragma unroll
                for (int e = 0; e < 4; ++e) x[mt][nt][e] += s * gv[nt][e] * acc[mt][nt][e];
                *(f32x4*)(xp0 + (size_t)(mt * 16) * D + nt * 16) = x[mt][nt];
            }
    }
};
struct EpiF32 {
    float* C; int ldc, ncols;
    __device__ __forceinline__ void operator()(f32x4 (&acc)[4][4], int row0, int col0, int fr, int fq) const {
#pragma unroll
        for (int mt = 0; mt < 4; ++mt)
#pragma unroll
            for (int nt = 0; nt < 4; ++nt) {
                const int row = row0 + mt * 16 + fr, col = col0 + nt * 16 + fq * 4;
                if (col < ncols) *(f32x4*)(C + (size_t)row * ldc + col) = acc[mt][nt];
            }
    }
};
struct EpiBf16 {
    bf16_t* C; int ldc;
    __device__ __forceinline__ void operator()(f32x4 (&acc)[4][4], int row0, int col0, int fr, int fq) const {
#pragma unroll
        for (int mt = 0; mt < 4; ++mt)
#pragma unroll
            for (int nt = 0; nt < 4; ++nt) {
                const int row = row0 + mt * 16 + fr, col = col0 + nt * 16 + fq * 4;
                *(u32x2*)(C + (size_t)row * ldc + col) = pack4(acc[mt][nt]);
            }
    }
};
struct EpiBf16T {
    bf16_t* C; int ldc;
    __device__ __forceinline__ void operator()(f32x4 (&acc)[4][4], int row0, int col0, int fr, int fq) const {
#pragma unroll
        for (int mt = 0; mt < 4; ++mt)
#pragma unroll
            for (int nt = 0; nt < 4; ++nt) {
                const int row = row0 + mt * 16 + fr, col = col0 + nt * 16 + fq * 4;
                *(u32x2*)(C + (size_t)row * ldc + col) = pack4(acc[mt][nt]);
            }
    }
};
struct EpiSSMIn {
    bf16_t* ZXB; float* DTRAW;
    __device__ __forceinline__ void operator()(f32x4 (&acc)[4][4], int row0, int col0, int fr, int fq) const {
#pragma unroll
        for (int mt = 0; mt < 4; ++mt)
#pragma unroll
            for (int nt = 0; nt < 4; ++nt) {
                const int row = row0 + mt * 16 + fr, col = col0 + nt * 16 + fq * 4;
                if (col < 5120) *(u32x2*)(ZXB + (size_t)row * 5120 + col) = pack4(acc[mt][nt]);
                else if (col < 5184) *(f32x4*)(DTRAW + (size_t)row * 64 + (col - 5120)) = acc[mt][nt];
            }
    }
};
struct EpiQ {
    bf16_t* Q; const float* rope; float qscale;
    __device__ __forceinline__ void operator()(f32x4 (&acc)[4][4], int row0, int col0, int fr, int fq) const {
#pragma unroll
        for (int mt = 0; mt < 4; ++mt) {
            const int row = row0 + mt * 16 + fr;
            const int pos = (row - 4096) & 2047;
#pragma unroll
            for (int nt = 0; nt < 4; ++nt) {
                const int c16 = col0 + nt * 16, d16 = c16 % 96;
                f32x4 v = acc[mt][nt];
                if (row0 >= 4096 && d16 >= 64) {
                    const int axis = (d16 - 64) >> 4, ph = fq >> 1, f0 = (fq & 1) * 4;
                    f32x4 pr;
#pragma unroll
                    for (int e = 0; e < 4; ++e) pr[e] = __shfl_xor(v[e], 32);
                    const f32x4 cs = *(const f32x4*)(rope + pos * 32 + axis * 8 + f0), sn = *(const f32x4*)(rope + pos * 32 + 16 + axis * 8 + f0);
#pragma unroll
                    for (int e = 0; e < 4; ++e) v[e] = ph == 0 ? v[e] * cs[e] - pr[e] * sn[e] : v[e] * cs[e] + pr[e] * sn[e];
                }
#pragma unroll
                for (int e = 0; e < 4; ++e) v[e] *= qscale;
                *(u32x2*)(Q + (size_t)row * 1536 + c16 + fq * 4) = pack4(v);
            }
        }
    }
};

template <class Epi>
__device__ __forceinline__ void gemm_tiles(const bf16_t* A, int lda, const bf16_t* Bt, int ldb, int M, int N, int K, const Epi& epi, unsigned char* smem, int rot) {
    constexpr int AS = 72;
    bf16_t* As = (bf16_t*)smem;
    bf16_t* Bs = As + 2 * 256 * AS;
    const int tid = tid_opaque(), wid = __builtin_amdgcn_readfirstlane(tid >> 6), lane = tid & 63, fr = lane & 15, fq = lane >> 4;
    const int wm = wid >> 1, wn = wid & 1;
    const int nM = M >> 8, nN = N >> 7, nT = nM * nN, nk = K >> 6;
    const int G = gridDim.x;
    const int b = (bid_opaque() + G - (rot % G)) % G;
    const int lr = tid >> 3, lc = (tid & 7) * 8;
    for (int t = b; t < nT; t += G) {
        const int tn = t / nM, tm = t % nM;
        const bf16_t* Ag = A + (size_t)(tm * 256 + lr) * lda + lc;
        const bf16_t* Bg = Bt + (size_t)(tn * 128 + lr) * ldb + lc;
        __syncthreads();
        f32x4 acc[4][4];
#pragma unroll
        for (int i = 0; i < 4; ++i)
#pragma unroll
            for (int j = 0; j < 4; ++j) acc[i][j] = (f32x4){0.f, 0.f, 0.f, 0.f};
        u32x4 ra0[4], rb0[2], ra1[4], rb1[2];
#define G_LOAD(RA, RB, kt_) { _Pragma("unroll") for (int i = 0; i < 4; ++i) RA[i] = *(const u32x4*)(Ag + (size_t)(64 * i) * lda + (kt_) * 64); \
                              _Pragma("unroll") for (int i = 0; i < 2; ++i) RB[i] = *(const u32x4*)(Bg + (size_t)(64 * i) * ldb + (kt_) * 64); }
#define G_STORE(RA, RB, buf_) { _Pragma("unroll") for (int i = 0; i < 4; ++i) *(u32x4*)(As + ((buf_) * 256 + lr + 64 * i) * AS + lc) = RA[i]; \
                                _Pragma("unroll") for (int i = 0; i < 2; ++i) *(u32x4*)(Bs + ((buf_) * 128 + lr + 64 * i) * AS + lc) = RB[i]; }
#define G_COMPUTE(cur_) { const bf16_t* Ac = As + ((cur_) * 256 + wm * 64 + fr) * AS + fq * 8; const bf16_t* Bc = Bs + ((cur_) * 128 + wn * 64 + fr) * AS + fq * 8; \
            _Pragma("unroll") for (int ks = 0; ks < 2; ++ks) { bf16x8 af[4], bfr[4]; \
                _Pragma("unroll") for (int mt = 0; mt < 4; ++mt) af[mt] = *(const bf16x8*)(Ac + mt * 16 * AS + ks * 32); \
                _Pragma("unroll") for (int nt = 0; nt < 4; ++nt) bfr[nt] = *(const bf16x8*)(Bc + nt * 16 * AS + ks * 32); \
                _Pragma("unroll") for (int mt = 0; mt < 4; ++mt) _Pragma("unroll") for (int nt = 0; nt < 4; ++nt) acc[mt][nt] = mfma16(bfr[nt], af[mt], acc[mt][nt]); } }
        G_LOAD(ra0, rb0, 0);
        G_LOAD(ra1, rb1, 1);
        G_STORE(ra0, rb0, 0);
        __syncthreads();
        for (int kt = 0; kt < nk; kt += 2) {
            { const int k2 = kt + 2 < nk ? kt + 2 : kt; G_LOAD(ra0, rb0, k2); }
            G_COMPUTE(0);
            G_STORE(ra1, rb1, 1);
            __syncthreads();
            { const int k3 = kt + 3 < nk ? kt + 3 : kt + 1; G_LOAD(ra1, rb1, k3); }
            G_COMPUTE(1);
            if (kt + 2 < nk) G_STORE(ra0, rb0, 0);
            __syncthreads();
        }
#undef G_LOAD
#undef G_STORE
#undef G_COMPUTE
        epi(acc, tm * 256 + wm * 64, tn * 128 + wn * 64, fr, fq);
    }
}


namespace pg8 {
#define PG8_LAS __attribute__((address_space(3)))
constexpr int BM = 256, BK = 64, HALF = 128, HTB = HALF * BK * 2, NXCD = 8, WGM = 8;
__device__ __forceinline__ int lds_byte(int r, int c) { const int st = (r >> 4) * 2 + (c >> 5), rr = r & 15, cc = c & 31, ob = rr * 64 + cc * 2; return st * 1024 + (ob ^ (((ob >> 9) & 1) << 5)); }
__device__ __forceinline__ void stage_rc(int b, int& R, int& C) { const int st = b / 1024, sb = b % 1024, swz = sb ^ (((sb >> 9) & 1) << 5); R = (st >> 1) * 16 + swz / 64; C = (st & 1) * 32 + (swz % 64) / 2; }
__device__ __forceinline__ int perm32(int rho) { const int n = rho >> 4, i = rho & 15; return 8 * (i >> 2) + 4 * n + (i & 3); }
struct Unit { int pm, pn; };
struct StaticOrder {
    int nM, nN, nwg, G, c;
    __device__ void init(int M, int N, int G_, int c_) { nM = M / BM; nN = N / BM; nwg = nM * nN; G = G_; c = c_; }
    __device__ bool next(int i, Unit& u) const {
        const long L = (long)i * G + c; if (L >= nwg) return false;
        int wgid = (int)L; { const int q = nwg / NXCD, r = nwg % NXCD, xcd = wgid % NXCD, off = wgid / NXCD; wgid = (xcd < r ? xcd * (q + 1) : r * (q + 1) + (xcd - r) * q) + off; }
        const int nig = WGM * nN, gid = wgid / nig, fm = gid * WGM, gsz = (nM - fm) < WGM ? (nM - fm) : WGM;
        u.pm = fm + ((wgid % nig) % gsz); u.pn = (wgid % nig) / gsz; return true;
    }
};
template <class Epi, class Sched>
__device__ __forceinline__ void gemm_phase(PG8_LAS unsigned char* lds, const bf16_t* A, const bf16_t* Bt, int K, const Sched& S, const Epi& E) {
    const int tid = tid_opaque(), wid = __builtin_amdgcn_readfirstlane(tid >> 6), lane = tid & 63, wr = wid >> 2, wc = wid & 3, fr = lane & 15, fq = lane >> 4;
    const int nt = K / BK;
    unsigned voffA[2], voffB[2];
#pragma unroll
    for (int i = 0; i < 2; ++i) { int R, C; stage_rc(tid * 16 + i * 8192, R, C); const int Rb = Epi::PERM ? ((R & ~31) + perm32(R & 31)) : R;
        voffA[i] = (unsigned)(R * K + C) * 2u; voffB[i] = (unsigned)(Rb * K + C) * 2u; }
    const size_t kstep = (size_t)(BK * 2);
    const size_t hstep = (size_t)HALF * K * 2;
    const size_t tstep = 2 * hstep;
    const unsigned ldsw = (unsigned)wid * 1024u;
    const int aoff = lds_byte(wr * 64 + fr, fq * 8), boff = lds_byte(wc * 32 + fr, fq * 8);
#define PG8_SA(b, h) (((b) * 2 + (h)) * HTB)
#define PG8_SB(b, h) ((4 + (b) * 2 + (h)) * HTB)
#define PG8_STAGE(bufoff, gbase, voff) do { _Pragma("unroll") for (int _i = 0; _i < 2; ++_i) \
        __builtin_amdgcn_global_load_lds((const unsigned*)((const char*)(gbase) + (voff)[_i]), (PG8_LAS unsigned*)(lds + (bufoff) + ldsw + _i * 8192), 16, 0, 0); } while (0)
#define PG8_LDA(dst, b, h) do { _Pragma("unroll") for (int m = 0; m < 4; ++m) _Pragma("unroll") for (int k = 0; k < 2; ++k) dst[m][k] = *(const PG8_LAS bf16x8*)(lds + PG8_SA(b, h) + aoff + m * 2048 + k * 1024); } while (0)
#define PG8_LDB(dst, b, h) do { _Pragma("unroll") for (int n = 0; n < 2; ++n) _Pragma("unroll") for (int k = 0; k < 2; ++k) dst[n][k] = *(const PG8_LAS bf16x8*)(lds + PG8_SB(b, h) + boff + n * 2048 + k * 1024); } while (0)
#define PG8_MMA(ai, bj, At, Bt) do { __builtin_amdgcn_s_setprio(1); _Pragma("unroll") for (int m = 0; m < 4; ++m) _Pragma("unroll") for (int n = 0; n < 2; ++n) _Pragma("unroll") for (int k = 0; k < 2; ++k) \
        acc[ai][bj][m][n] = __builtin_amdgcn_mfma_f32_16x16x32_bf16(Bt[n][k], At[m][k], acc[ai][bj][m][n], 0, 0, 0); __builtin_amdgcn_s_setprio(0); } while (0)
#define PG8_WAIT_V(n) asm volatile("s_waitcnt vmcnt(" #n ")" ::: "memory")
#define PG8_WAIT_L(n) asm volatile("s_waitcnt lgkmcnt(" #n ")" ::: "memory")
#define PG8_BAR __builtin_amdgcn_s_barrier()
#define PG8_SCHED __builtin_amdgcn_sched_barrier(0)
    Unit cur, nxt; int ui = 0;
    if (!S.next(0, cur)) return;
    f32x4 acc[2][2][4][2];
#pragma unroll
    for (int a = 0; a < 2; ++a)
#pragma unroll
        for (int b = 0; b < 2; ++b)
#pragma unroll
            for (int m = 0; m < 4; ++m)
#pragma unroll
                for (int n = 0; n < 2; ++n) acc[a][b][m][n] = (f32x4){0.f, 0.f, 0.f, 0.f};
    bf16x8 At[4][2], B0[2][2], B1[2][2];
    const char* cA = (const char*)A + (size_t)cur.pm * tstep; const char* cB = (const char*)Bt + (size_t)cur.pn * tstep;
    PG8_STAGE(PG8_SB(0, 0), cB, voffB); PG8_STAGE(PG8_SA(0, 0), cA, voffA); PG8_STAGE(PG8_SB(0, 1), cB + hstep, voffB); PG8_STAGE(PG8_SA(0, 1), cA + hstep, voffA);
    if (wr == 1) PG8_BAR;
    PG8_WAIT_V(4); PG8_BAR;
    PG8_STAGE(PG8_SB(1, 0), cB + kstep, voffB); PG8_STAGE(PG8_SA(1, 0), cA + kstep, voffA); PG8_STAGE(PG8_SB(1, 1), cB + hstep + kstep, voffB);
    PG8_WAIT_V(6); PG8_BAR;
    for (;;) {
        const bool has_next = S.next(ui + 1, nxt);
        const char* nA = has_next ? (const char*)A + (size_t)nxt.pm * tstep : cA; const char* nB = has_next ? (const char*)Bt + (size_t)nxt.pn * tstep : cB;
        for (int t = 0; t < nt; t += 2) {
            const bool last = (t == nt - 2);
            const char* a1 = cA + (size_t)(t + 1) * kstep;
            const char* a2 = last ? nA : cA + (size_t)(t + 2) * kstep; const char* b2 = last ? nB : cB + (size_t)(t + 2) * kstep;
            const char* a3 = a2 + kstep; const char* b3 = b2 + kstep;
            PG8_LDB(B0, 0, 0); PG8_SCHED; PG8_LDA(At, 0, 0); PG8_STAGE(PG8_SA(1, 1), a1 + hstep, voffA);
            PG8_WAIT_L(8); PG8_BAR; PG8_WAIT_L(0); PG8_MMA(0, 0, At, B0); PG8_BAR; PG8_SCHED;
            PG8_LDB(B1, 0, 1); PG8_STAGE(PG8_SB(0, 0), b2, voffB);
            PG8_BAR; PG8_WAIT_L(0); PG8_MMA(0, 1, At, B1); PG8_BAR;
            PG8_LDA(At, 0, 1); PG8_STAGE(PG8_SA(0, 0), a2, voffA);
            PG8_BAR; PG8_WAIT_L(0); PG8_MMA(1, 0, At, B0); PG8_BAR; PG8_SCHED;
            PG8_STAGE(PG8_SB(0, 1), b2 + hstep, voffB);
            PG8_WAIT_V(6); PG8_BAR; PG8_MMA(1, 1, At, B1); PG8_BAR;
            PG8_LDB(B0, 1, 0); PG8_SCHED; PG8_LDA(At, 1, 0); PG8_STAGE(PG8_SA(0, 1), a2 + hstep, voffA);
            PG8_WAIT_L(8); PG8_BAR; PG8_WAIT_L(0); PG8_MMA(0, 0, At, B0); PG8_BAR; PG8_SCHED;
            PG8_LDB(B1, 1, 1); PG8_STAGE(PG8_SB(1, 0), b3, voffB);
            PG8_BAR; PG8_WAIT_L(0); PG8_MMA(0, 1, At, B1); PG8_BAR;
            PG8_LDA(At, 1, 1); PG8_STAGE(PG8_SA(1, 0), a3, voffA);
            PG8_BAR; PG8_WAIT_L(0); PG8_MMA(1, 0, At, B0); PG8_BAR; PG8_SCHED;
            PG8_STAGE(PG8_SB(1, 1), b3 + hstep, voffB);
            PG8_WAIT_V(6); PG8_BAR; PG8_MMA(1, 1, At, B1); PG8_BAR;
        }
        E(acc, cur, wr, wc, fr, fq);
        if (!has_next) break;
#pragma unroll
        for (int a = 0; a < 2; ++a)
#pragma unroll
            for (int b = 0; b < 2; ++b)
#pragma unroll
                for (int m = 0; m < 4; ++m)
#pragma unroll
                    for (int n = 0; n < 2; ++n) acc[a][b][m][n] = (f32x4){0.f, 0.f, 0.f, 0.f};
        cur = nxt; cA = nA; cB = nB; ++ui;
    }
    PG8_WAIT_V(0);
    if (wr == 0) PG8_BAR;
    PG8_BAR;
#undef PG8_SA
#undef PG8_SB
#undef PG8_STAGE
#undef PG8_LDA
#undef PG8_LDB
#undef PG8_MMA
#undef PG8_WAIT_V
#undef PG8_WAIT_L
#undef PG8_BAR
#undef PG8_SCHED
}
}

struct Epi8SwiGLU {
    static constexpr bool PERM = false;
    bf16_t* U;
    __device__ __forceinline__ void operator()(const f32x4 (&acc)[2][2][4][2], const pg8::Unit& u, int wr, int wc, int fr, int fq) const {
#pragma unroll
        for (int ai = 0; ai < 2; ++ai)
#pragma unroll
            for (int m = 0; m < 4; ++m) {
                const int row = u.pm * 256 + ai * 128 + wr * 64 + m * 16 + fr;
#pragma unroll
                for (int n = 0; n < 2; ++n) {
                    f32x4 o;
#pragma unroll
                    for (int e = 0; e < 4; ++e) o[e] = silu_f(acc[ai][0][m][n][e]) * acc[ai][1][m][n][e];
                    *(u32x2*)(U + (size_t)row * DFF + u.pn * 128 + wc * 32 + n * 16 + fq * 4) = pack4(o);
                }
            }
    }
};
struct Epi8SSMIn {
    static constexpr bool PERM = false;
    bf16_t* ZXB; float* DTRAW;
    __device__ __forceinline__ void operator()(const f32x4 (&acc)[2][2][4][2], const pg8::Unit& u, int wr, int wc, int fr, int fq) const {
#pragma unroll
        for (int ai = 0; ai < 2; ++ai)
#pragma unroll
            for (int m = 0; m < 4; ++m) {
                const int row = u.pm * 256 + ai * 128 + wr * 64 + m * 16 + fr;
#pragma unroll
                for (int bj = 0; bj < 2; ++bj)
#pragma unroll
                    for (int n = 0; n < 2; ++n) {
                        const int col = u.pn * 256 + bj * 128 + wc * 32 + n * 16 + fq * 4;
                        if (col < 5120) *(u32x2*)(ZXB + (size_t)row * 5120 + col) = pack4(acc[ai][bj][m][n]);
                        else if (col < 5184) *(f32x4*)(DTRAW + (size_t)row * 64 + (col - 5120)) = acc[ai][bj][m][n];
                    }
            }
    }
};

__device__ __forceinline__ void phase_mlanorm(const float* __restrict__ QKVA, const float* __restrict__ qn, const float* __restrict__ kvn, const float* __restrict__ cache, int j,
                              const float* __restrict__ rope, bf16_t* __restrict__ QA, bf16_t* __restrict__ CKV, bf16_t* __restrict__ KR, float* __restrict__ out_cache) {
    const int tid_ = tid_opaque(); const int lane = tid_ & 63, gw = bid_opaque() * 8 + (tid_ >> 6), nW = gridDim.x * 8;
    for (int tok = gw; tok < NTOKKV; tok += nW) {
        if (tok < NTOK) {
            const float* r = QKVA + (size_t)tok * 800;
            const f32x4 q0 = *(const f32x4*)(r + lane * 4), q1 = *(const f32x4*)(r + 256 + lane * 4), kv = *(const f32x4*)(r + 512 + lane * 4);
            const float kr = lane < 32 ? r[768 + lane] : 0.f;
            float sq = 0.f, sk = 0.f;
#pragma unroll
            for (int e = 0; e < 4; ++e) { sq += q0[e] * q0[e] + q1[e] * q1[e]; sk += kv[e] * kv[e]; }
            const float rq = rsqrtf(wave_sum(sq) * (1.f / 512) + EPS), rk = rsqrtf(wave_sum(sk) * (1.f / 256) + EPS);
            const f32x4 g0 = *(const f32x4*)(qn + lane * 4), g1 = *(const f32x4*)(qn + 256 + lane * 4), gk = *(const f32x4*)(kvn + lane * 4);
            f32x4 a0, a1, ck;
#pragma unroll
            for (int e = 0; e < 4; ++e) { a0[e] = q0[e] * rq * g0[e]; a1[e] = q1[e] * rq * g1[e]; ck[e] = kv[e] * rk * gk[e]; }
            *(u32x2*)(QA + (size_t)tok * 512 + lane * 4) = pack4(a0);
            *(u32x2*)(QA + (size_t)tok * 512 + 256 + lane * 4) = pack4(a1);
            *(u32x2*)(CKV + (size_t)tok * 256 + lane * 4) = pack4(ck);
            float krv = kr;
            if (tok < 4096) {
                float* o = out_cache + ((size_t)((tok >> 8) * 2 + j) * 256 + (tok & 255)) * 288;
                *(f32x4*)(o + lane * 4) = ck;
                if (lane < 32) o[256 + lane] = kr;
            } else {
                const int pos = (tok - 4096) & 2047;
                const float partner = __shfl_xor(kr, 8);
                const int l31 = lane & 31, axis = l31 >> 4, ph = (l31 >> 3) & 1, f = l31 & 7;
                const float cs = rope[pos * 32 + axis * 8 + f], sn = rope[pos * 32 + 16 + axis * 8 + f];
                krv = ph == 0 ? kr * cs - partner * sn : kr * cs + partner * sn;
            }
            if (lane < 32) KR[(size_t)tok * 32 + lane] = f2bf(krv);
        } else {
            const int ct = tok - NTOK, bb = ct >> 8, pp = ct & 255;
            const float* c = cache + ((size_t)(bb * 2 + j) * 256 + pp) * 288;
            const f32x4 kv = *(const f32x4*)(c + lane * 4);
            *(u32x2*)(CKV + (size_t)tok * 256 + lane * 4) = pack4(kv);
            if (lane < 32) KR[(size_t)tok * 32 + lane] = f2bf(c[256 + lane]);
        }
    }
}

__device__ __forceinline__ void phase_attn(const bf16_t* __restrict__ Q, const bf16_t* __restrict__ KN, const bf16_t* __restrict__ KR, const bf16_t* __restrict__ VT, bf16_t* __restrict__ O, unsigned char* smem) {
    constexpr int KS = 104, VS = 72;
    bf16_t* Ks = (bf16_t*)smem;
    bf16_t* Vs = Ks + 2 * 64 * KS;
    const int tid = tid_opaque(), wid = __builtin_amdgcn_readfirstlane(tid >> 6), lane = tid & 63, fr = lane & 15, fq = lane >> 4;
    const int G = gridDim.x, b = bid_opaque();
    const int lrow = tid >> 3, lc8 = (tid & 7) * 8, rrow = (tid >> 2) & 63, rc8 = (tid & 3) * 8;
    for (int it = 0;; ++it) {
        const int idx = (it >> 1) * G + b;
        if (idx >= 256) break;
        const bool samp = (it & 1) == 0;
        int head, q0, nkt, sb = 0, kbase = 0;
        if (samp) { sb = idx >> 7; const int rem = idx & 127; head = rem >> 3; q0 = 4096 + sb * 2048 + (rem & 7) * 256; nkt = 36; }
        else { const int seq = idx >> 4; head = idx & 15; q0 = seq * 256; nkt = 4; kbase = seq * 256; }
        bf16x8 qf[2][3];
#pragma unroll
        for (int g = 0; g < 2; ++g)
#pragma unroll
            for (int ks = 0; ks < 3; ++ks) qf[g][ks] = *(const bf16x8*)(Q + (size_t)(q0 + wid * 32 + g * 16 + fr) * 1536 + head * 96 + ks * 32 + fq * 8);
        f32x4 ot[2][4];
#pragma unroll
        for (int g = 0; g < 2; ++g)
#pragma unroll
            for (int i = 0; i < 4; ++i) ot[g][i] = (f32x4){0.f, 0.f, 0.f, 0.f};
        float m[2] = {-1e30f, -1e30f}, l[2] = {0.f, 0.f};
        u32x4 rk, rr = {0u, 0u, 0u, 0u}, rv;
#define ATT_TB(kt) (samp ? ((kt) < 4 ? NTOK + sb * 256 + (kt) * 64 : 4096 + sb * 2048 + ((kt) - 4) * 64) : kbase + (kt) * 64)
#define ATT_GLOAD(kt) { const int tb = ATT_TB(kt); rk = *(const u32x4*)(KN + (size_t)(tb + lrow) * 1024 + head * 64 + lc8); \
            if (tid < 256) rr = *(const u32x4*)(KR + (size_t)(tb + rrow) * 32 + rc8); \
            rv = *(const u32x4*)(VT + (size_t)(head * 64 + lrow) * NTOKKV + tb + lc8); }
#define ATT_LSTORE(buf) { *(u32x4*)(Ks + ((buf) * 64 + lrow) * KS + lc8) = rk; if (tid < 256) *(u32x4*)(Ks + ((buf) * 64 + rrow) * KS + 64 + rc8) = rr; \
            *(u32x4*)(Vs + ((buf) * 64 + lrow) * VS + lc8) = rv; }
        ATT_GLOAD(0); ATT_LSTORE(0);
        __syncthreads();
#pragma unroll 1
        for (int kt = 0; kt < nkt; ++kt) {
            const int cur = kt & 1;
            if (kt + 1 < nkt) ATT_GLOAD(kt + 1);
            f32x4 st[2][4];
#pragma unroll
            for (int jt = 0; jt < 4; ++jt) {
                st[0][jt] = (f32x4){0.f, 0.f, 0.f, 0.f}; st[1][jt] = (f32x4){0.f, 0.f, 0.f, 0.f};
#pragma unroll
                for (int ks = 0; ks < 3; ++ks) {
                    const bf16x8 a = *(const bf16x8*)(Ks + (cur * 64 + jt * 16 + fr) * KS + ks * 32 + fq * 8);
                    st[0][jt] = mfma16(a, qf[0][ks], st[0][jt]);
                    st[1][jt] = mfma16(a, qf[1][ks], st[1][jt]);
                }
                asm volatile("" ::: "memory");
            }
            union { u32x4 u; bf16x8 v; } pb[2][2];
#pragma unroll
            for (int g = 0; g < 2; ++g) {
                float mloc = st[g][0][0];
#pragma unroll
                for (int jt = 0; jt < 4; ++jt)
#pragma unroll
                    for (int e = 0; e < 4; ++e) mloc = fmaxf(mloc, st[g][jt][e]);
                mloc = fmaxf(mloc, __shfl_xor(mloc, 16)); mloc = fmaxf(mloc, __shfl_xor(mloc, 32));
                const float mn = fmaxf(m[g], mloc), alpha = __builtin_amdgcn_exp2f(m[g] - mn);
                m[g] = mn;
                float psum = 0.f;
#pragma unroll
                for (int jt = 0; jt < 4; ++jt)
#pragma unroll
                    for (int e = 0; e < 4; ++e) { st[g][jt][e] = __builtin_amdgcn_exp2f(st[g][jt][e] - mn); psum += st[g][jt][e]; }
                l[g] = l[g] * alpha + psum;
#pragma unroll
                for (int i = 0; i < 4; ++i) ot[g][i] *= alpha;
#pragma unroll
                for (int s = 0; s < 2; ++s) {
                    pb[g][s].u.x = pk2(st[g][2 * s][0], st[g][2 * s][1]); pb[g][s].u.y = pk2(st[g][2 * s][2], st[g][2 * s][3]);
                    pb[g][s].u.z = pk2(st[g][2 * s + 1][0], st[g][2 * s + 1][1]); pb[g][s].u.w = pk2(st[g][2 * s + 1][2], st[g][2 * s + 1][3]);
                }
            }
#pragma unroll
            for (int s = 0; s < 2; ++s)
#pragma unroll
                for (int dvt = 0; dvt < 4; ++dvt) {
                    const bf16_t* vp = Vs + (cur * 64 + dvt * 16 + fr) * VS + s * 32 + fq * 4;
                    union { u32x4 u; bf16x8 v; } va;
                    const u32x2 lo = *(const u32x2*)vp, hi = *(const u32x2*)(vp + 16);
                    va.u.x = lo.x; va.u.y = lo.y; va.u.z = hi.x; va.u.w = hi.y;
                    ot[0][dvt] = mfma16(va.v, pb[0][s].v, ot[0][dvt]);
                    ot[1][dvt] = mfma16(va.v, pb[1][s].v, ot[1][dvt]);
                    asm volatile("" ::: "memory");
                }
            if (kt + 1 < nkt) ATT_LSTORE(cur ^ 1);
            __syncthreads();
        }
#pragma unroll
        for (int g = 0; g < 2; ++g) {
            float lt = l[g];
            lt += __shfl_xor(lt, 16); lt += __shfl_xor(lt, 32);
            const float inv = 1.f / lt;
#pragma unroll
            for (int dvt = 0; dvt < 4; ++dvt) {
                f32x4 o = ot[g][dvt] * inv;
                *(u32x2*)(O + (size_t)(q0 + wid * 32 + g * 16 + fr) * 1024 + head * 64 + dvt * 16 + fq * 4) = pack4(o);
            }
        }
    }
#undef ATT_TB
#undef ATT_GLOAD
#undef ATT_LSTORE
}


__device__ __forceinline__ void phase_conv(const bf16_t* __restrict__ ZXB, const float* __restrict__ DTRAW, const float* __restrict__ cw, const float* __restrict__ cb, const float* __restrict__ dtb,
                           bf16_t* __restrict__ XS, bf16_t* __restrict__ XT, bf16_t* __restrict__ BM, bf16_t* __restrict__ BT, bf16_t* __restrict__ CM, float* __restrict__ DT, unsigned char* smem) {
    float* in = (float*)smem;
    bf16_t* ot = (bf16_t*)(smem + 34560);
    const int tid = tid_opaque(), G = gridDim.x;
    u32x4 pv[3];
#define CONV_LOAD(item_) { const int chunk_ = (item_) / 48, slab_ = (item_) % 48, t0_ = chunk_ * 128; int lo_, hi_; \
        if (chunk_ < 32) { lo_ = (chunk_ >> 1) * 256; hi_ = lo_ + 256; } else { lo_ = 4096 + ((chunk_ - 32) >> 4) * 2048; hi_ = lo_ + 2048; } \
        _Pragma("unroll") for (int k = 0; k < 3; ++k) { const int c = tid + k * NT, r = c >> 3, kc = c & 7, t = t0_ - 2 + r; pv[k] = (u32x4){0u, 0u, 0u, 0u}; \
            if (c < 132 * 8 && t >= lo_ && t < hi_) pv[k] = *(const u32x4*)(ZXB + (size_t)t * 5120 + 2048 + slab_ * 64 + kc * 8); } }
    const int item0 = bid_opaque();
    if (item0 < 64 * 48) CONV_LOAD(item0);
    for (int item = item0; item < 64 * 48; item += G) {
        const int chunk = item / 48, slab = item % 48, t0 = chunk * 128;
#pragma unroll
        for (int k = 0; k < 3; ++k) {
            const int c = tid + k * NT, r = c >> 3, kc = c & 7;
            if (c < 132 * 8) {
                const u32x4 v = pv[k];
                float* d = in + r * 65 + kc * 8;
                d[0] = bflo(v.x); d[1] = bfhi(v.x); d[2] = bflo(v.y); d[3] = bfhi(v.y); d[4] = bflo(v.z); d[5] = bfhi(v.z); d[6] = bflo(v.w); d[7] = bfhi(v.w);
            }
        }
        __syncthreads();
        if (item + G < 64 * 48) CONV_LOAD(item + G);
        {
            const int ch = tid & 63, tg = tid >> 6, cg_ = slab * 64 + ch;
            const float w0 = cw[cg_], w1 = cw[3072 + cg_], w2 = cw[2 * 3072 + cg_], w3 = cw[3 * 3072 + cg_], w4 = cw[4 * 3072 + cg_], bias = cb[cg_];
            const float* ip = in + (tg * 16) * 65 + ch;
            float x0 = ip[0], x1 = ip[65], x2 = ip[130], x3 = ip[195];
#pragma unroll
            for (int tt = 0; tt < 16; ++tt) {
                const float x4 = ip[(tt + 4) * 65];
                const float a = bias + x0 * w0 + x1 * w1 + x2 * w2 + x3 * w3 + x4 * w4;
                ot[(tg * 16 + tt) * 66 + ch] = f2bf(silu_f(a));
                x0 = x1; x1 = x2; x2 = x3; x3 = x4;
            }
        }
        __syncthreads();
        bf16_t* dst; int ld, col; bf16_t* tdst = nullptr;
        if (slab < 32) { dst = XS; ld = 2048; col = slab * 64; tdst = XT + ((size_t)chunk * 2048 + slab * 64) * 128; }
        else if (slab < 40) { dst = BM; ld = 512; col = (slab - 32) * 64; tdst = BT + ((size_t)chunk * 512 + (slab - 32) * 64) * 128; }
        else { dst = CM; ld = 512; col = (slab - 40) * 64; }
#pragma unroll
        for (int i = 0; i < 2; ++i) {
            const int c = tid + i * NT, r = c >> 3, kc = c & 7;
            const unsigned* s32 = (const unsigned*)ot + r * 33 + kc * 4;
            u32x4 o; o.x = s32[0]; o.y = s32[1]; o.z = s32[2]; o.w = s32[3];
            *(u32x4*)(dst + (size_t)(t0 + r) * ld + col + kc * 8) = o;
        }
        if (tdst) {
#pragma unroll
            for (int i = 0; i < 2; ++i) {
                const int c = tid + i * NT, chh = c >> 4, jc = c & 15;
                const bf16_t* s = ot + (jc * 8) * 66 + chh;
                u32x4 o;
                o.x = (unsigned)s[0] | ((unsigned)s[66] << 16); o.y = (unsigned)s[2 * 66] | ((unsigned)s[3 * 66] << 16);
                o.z = (unsigned)s[4 * 66] | ((unsigned)s[5 * 66] << 16); o.w = (unsigned)s[6 * 66] | ((unsigned)s[7 * 66] << 16);
                *(u32x4*)(tdst + (size_t)chh * 128 + jc * 8) = o;
            }
        }
    }
#undef CONV_LOAD
    __syncthreads();
    for (int i = bid_opaque() * NT + tid; i < NTOK * 64; i += G * NT) {
        const float v = DTRAW[i] + dtb[i & 63];
        DT[i] = v > 20.f ? v : log1pf(__expf(v));
    }
}

__device__ __forceinline__ void phase_ssd(const bf16_t* __restrict__ XT, const bf16_t* __restrict__ BM, const bf16_t* __restrict__ BT, const bf16_t* __restrict__ CM, const float* __restrict__ DT,
                          const float* __restrict__ a_log, const float* __restrict__ state_in, int j, bf16_t* __restrict__ YF, bf16_t* __restrict__ YB, float* __restrict__ out_state, unsigned char* smem) {
    constexpr int LS = 136;
    bf16_t* Cs = (bf16_t*)smem;
    bf16_t* Bs = Cs + 128 * LS;
    bf16_t* BTs = Bs + 128 * LS;
    bf16_t* XTs = BTs + 128 * LS;
    bf16_t* Hs = XTs + 64 * LS;
    float* cum = (float*)(Hs + 64 * LS);
    float* dts = cum + 128;
    float* wj = dts + 128;
    float* misc = wj + 128;
    const int tid = tid_opaque(), wid = __builtin_amdgcn_readfirstlane(tid >> 6), lane = tid & 63, fr = lane & 15, fq = lane >> 4;
    const int G = gridDim.x;
    const int strip = wid < 4 ? wid : 11 - wid;
    const int pt = wid & 3, nt0 = (wid >> 2) * 4;
    const int lr = tid >> 4, lc = (tid & 15) * 8;
    const int irow = strip * 16 + fr;
    for (int w = bid_opaque(); w < 256; w += G) {
        const bool samp = w < 128;
#define SSD_DECODE(step_, seq_, dir_, head_, t0_, first_, last_) { \
            if (samp) { seq_ = w >> 6; dir_ = (w >> 5) & 1; head_ = w & 31; const int c_ = dir_ ? 15 - (step_) : (step_); t0_ = 4096 + seq_ * 2048 + c_ * 128; first_ = (step_) == 0; last_ = (step_) == 15; } \
            else { const int pu_ = (w - 128) * 8 + ((step_) >> 1); seq_ = pu_ >> 6; dir_ = (pu_ >> 5) & 1; head_ = pu_ & 31; const int cc_ = (step_) & 1, c_ = dir_ ? 1 - cc_ : cc_; t0_ = seq_ * 256 + c_ * 128; first_ = cc_ == 0; last_ = cc_ == 1; } }
        u32x4 rC[4], rB[4], rBT[4], rX[2]; float rd0 = 0.f, rd1 = 0.f;
#define SSD_ISSUE(step_) { int seq_n, dir_n, head_n, t0_n; bool f_n, l_n; SSD_DECODE(step_, seq_n, dir_n, head_n, t0_n, f_n, l_n); (void)f_n; (void)l_n; (void)seq_n; \
            const int grp_n = head_n >> 3, chunk_n = t0_n >> 7; \
            if (wid == 0) { rd0 = DT[(size_t)(t0_n + lane) * 64 + dir_n * 32 + head_n]; rd1 = DT[(size_t)(t0_n + 64 + lane) * 64 + dir_n * 32 + head_n]; } \
            _Pragma("unroll") for (int i = 0; i < 4; ++i) { const int r = lr + 32 * i; \
                rC[i] = *(const u32x4*)(CM + (size_t)(t0_n + r) * 512 + grp_n * 128 + lc); \
                rB[i] = *(const u32x4*)(BM + (size_t)(t0_n + r) * 512 + grp_n * 128 + lc); \
                rBT[i] = *(const u32x4*)(BT + ((size_t)chunk_n * 512 + grp_n * 128 + r) * 128 + lc); } \
            _Pragma("unroll") for (int i = 0; i < 2; ++i) { const int r = lr + 32 * i; rX[i] = *(const u32x4*)(XT + ((size_t)chunk_n * 2048 + head_n * 64 + r) * 128 + lc); } }
        SSD_ISSUE(0);
        f32x4 hacc[4];
#pragma unroll
        for (int k = 0; k < 4; ++k) hacc[k] = (f32x4){0.f, 0.f, 0.f, 0.f};
        for (int step = 0; step < 16; ++step) {
            int seq, dir, head, t0; bool first, last;
            SSD_DECODE(step, seq, dir, head, t0, first, last);
            const float A2 = -__expf(a_log[dir * 32 + head]) * 1.44269504f;
            bf16_t* Y = dir ? YB : YF;
            const size_t sbase = ((((size_t)(seq * 2 + j) * 2 + dir) * 32 + head) * 64 + pt * 16 + fr) * 128 + fq * 4;
            if (first) {
#pragma unroll
                for (int k = 0; k < 4; ++k) hacc[k] = samp ? *(const f32x4*)(state_in + sbase + (nt0 + k) * 16) : (f32x4){0.f, 0.f, 0.f, 0.f};
            }
#pragma unroll
            for (int k = 0; k < 4; ++k) *(u32x2*)(Hs + (pt * 16 + fr) * LS + (nt0 + k) * 16 + fq * 4) = pack4(hacc[k]);
#pragma unroll
            for (int i = 0; i < 4; ++i) {
                const int r = lr + 32 * i;
                *(u32x4*)(Cs + r * LS + lc) = rC[i]; *(u32x4*)(Bs + r * LS + lc) = rB[i]; *(u32x4*)(BTs + r * LS + lc) = rBT[i];
            }
#pragma unroll
            for (int i = 0; i < 2; ++i) *(u32x4*)(XTs + (lr + 32 * i) * LS + lc) = rX[i];
            if (wid == 0) {
                const float d0 = rd0, d1 = rd1;
                const float v0 = d0 * A2, v1 = d1 * A2;
                float p0 = v0, p1 = v1;
#pragma unroll
                for (int o = 1; o < 64; o <<= 1) { const float a = __shfl_up(p0, o), bq = __shfl_up(p1, o); if (lane >= o) { p0 += a; p1 += bq; } }
                p1 += __shfl(p0, 63);
                const float total = __shfl(p1, 63);
                const float c0 = dir ? total - p0 + v0 : p0, c1 = dir ? total - p1 + v1 : p1;
                cum[lane] = c0; cum[64 + lane] = c1; dts[lane] = d0; dts[64 + lane] = d1;
                wj[lane] = d0 * __builtin_amdgcn_exp2f(total - c0); wj[64 + lane] = d1 * __builtin_amdgcn_exp2f(total - c1);
                if (lane == 0) misc[0] = total;
            }
            __syncthreads();
            if (step + 1 < 16) SSD_ISSUE(step + 1);
            const float ci = cum[irow];
            bf16x8 cf[4];
#pragma unroll
            for (int ns = 0; ns < 4; ++ns) cf[ns] = *(const bf16x8*)(Cs + irow * LS + ns * 32 + fq * 8);
            f32x4 yo[4];
#pragma unroll
            for (int i = 0; i < 4; ++i) yo[i] = (f32x4){0.f, 0.f, 0.f, 0.f};
#pragma unroll
            for (int ns = 0; ns < 4; ++ns)
#pragma unroll
                for (int pp = 0; pp < 4; ++pp) {
                    const bf16x8 a = *(const bf16x8*)(Hs + (pp * 16 + fr) * LS + ns * 32 + fq * 8);
                    yo[pp] = mfma16(a, cf[ns], yo[pp]);
                }
            {
                const float e = __builtin_amdgcn_exp2f(ci);
#pragma unroll
                for (int i = 0; i < 4; ++i) yo[i] *= e;
            }
#pragma unroll
            for (int js = 0; js < 4; ++js) {
                const bool need0 = dir ? (2 * js >= strip) : (2 * js <= strip), need1 = dir ? (2 * js + 1 >= strip) : (2 * js + 1 <= strip);
                if (need0 || need1) {
                    f32x4 g2[2];
#pragma unroll
                    for (int h = 0; h < 2; ++h) {
                        const int jt = js * 2 + h;
                        f32x4 g = {0.f, 0.f, 0.f, 0.f};
                        if (h == 0 ? need0 : need1) {
#pragma unroll
                            for (int ns = 0; ns < 4; ++ns) {
                                const bf16x8 a = *(const bf16x8*)(Bs + (jt * 16 + fr) * LS + ns * 32 + fq * 8);
                                g = mfma16(a, cf[ns], g);
                            }
                            const f32x4 cj = *(const f32x4*)(cum + jt * 16 + fq * 4), dj = *(const f32x4*)(dts + jt * 16 + fq * 4);
                            if (jt == strip) {
#pragma unroll
                                for (int e = 0; e < 4; ++e) {
                                    const int jj = jt * 16 + fq * 4 + e;
                                    const bool ok = dir ? (jj >= irow) : (jj <= irow);
                                    g[e] = ok ? g[e] * __builtin_amdgcn_exp2f(fminf(ci - cj[e], 0.f)) * dj[e] : 0.f;
                                }
                            } else {
#pragma unroll
                                for (int e = 0; e < 4; ++e) g[e] = g[e] * __builtin_amdgcn_exp2f(fminf(ci - cj[e], 0.f)) * dj[e];
                            }
                        }
                        g2[h] = g;
                    }
                    union { u32x4 u; bf16x8 v; } mb;
                    mb.u.x = pk2(g2[0][0], g2[0][1]); mb.u.y = pk2(g2[0][2], g2[0][3]);
                    mb.u.z = pk2(g2[1][0], g2[1][1]); mb.u.w = pk2(g2[1][2], g2[1][3]);
#pragma unroll
                    for (int pp = 0; pp < 4; ++pp) {
                        const bf16_t* xp = XTs + (pp * 16 + fr) * LS + js * 32 + fq * 4;
                        union { u32x4 u; bf16x8 v; } va;
                        const u32x2 lo = *(const u32x2*)xp, hi = *(const u32x2*)(xp + 16);
                        va.u.x = lo.x; va.u.y = lo.y; va.u.z = hi.x; va.u.w = hi.y;
                        yo[pp] = mfma16(va.v, mb.v, yo[pp]);
                    }
                }
            }
#pragma unroll
            for (int pp = 0; pp < 4; ++pp) *(u32x2*)(Y + (size_t)(t0 + irow) * 2048 + head * 64 + pp * 16 + fq * 4) = pack4(yo[pp]);
            {
                const float dec = __builtin_amdgcn_exp2f(misc[0]);
#pragma unroll
                for (int k = 0; k < 4; ++k) hacc[k] *= dec;
#pragma unroll
                for (int js = 0; js < 4; ++js) {
                    const u32x4 xr = *(const u32x4*)(XTs + (pt * 16 + fr) * LS + js * 32 + fq * 8);
                    const f32x4 w0 = *(const f32x4*)(wj + js * 32 + fq * 8), w1 = *(const f32x4*)(wj + js * 32 + fq * 8 + 4);
                    union { u32x4 u; bf16x8 v; } xb;
                    xb.u.x = pk2(bflo(xr.x) * w0[0], bfhi(xr.x) * w0[1]); xb.u.y = pk2(bflo(xr.y) * w0[2], bfhi(xr.y) * w0[3]);
                    xb.u.z = pk2(bflo(xr.z) * w1[0], bfhi(xr.z) * w1[1]); xb.u.w = pk2(bflo(xr.w) * w1[2], bfhi(xr.w) * w1[3]);
#pragma unroll
                    for (int k = 0; k < 4; ++k) {
                        const bf16x8 a = *(const bf16x8*)(BTs + ((nt0 + k) * 16 + fr) * LS + js * 32 + fq * 8);
                        hacc[k] = mfma16(a, xb.v, hacc[k]);
                    }
                }
            }
            __syncthreads();
            if (last && !samp) {
#pragma unroll
                for (int k = 0; k < 4; ++k) *(f32x4*)(out_state + sbase + (nt0 + k) * 16) = hacc[k];
            }
        }
#undef SSD_DECODE
#undef SSD_ISSUE
    }
}

__device__ __forceinline__ void phase_gnorm(const bf16_t* __restrict__ YF, const bf16_t* __restrict__ YB, const bf16_t* __restrict__ XS, const bf16_t* __restrict__ ZXB, const float* __restrict__ dsk,
                            const float* __restrict__ ng, bf16_t* __restrict__ YN) {
    const int tid_ = tid_opaque(); const int lane = tid_ & 63, gw = bid_opaque() * 8 + (tid_ >> 6), nW = gridDim.x * 8;
#pragma unroll 2
    for (int tok = gw; tok < NTOK; tok += nW) {
        float v[4][8]; float ss = 0.f;
#pragma unroll
        for (int jj = 0; jj < 4; ++jj) {
            const int c = jj * 512 + lane * 8, head = c >> 6;
            const float ds = dsk[head] + dsk[32 + head];
            const u32x4 yf = *(const u32x4*)(YF + (size_t)tok * 2048 + c), yb = *(const u32x4*)(YB + (size_t)tok * 2048 + c);
            const u32x4 xs = *(const u32x4*)(XS + (size_t)tok * 2048 + c), z = *(const u32x4*)(ZXB + (size_t)tok * 5120 + c);
#pragma unroll
            for (int q = 0; q < 4; ++q) {
                const float y0 = bflo(yf[q]) + bflo(yb[q]) + ds * bflo(xs[q]), y1 = bfhi(yf[q]) + bfhi(yb[q]) + ds * bfhi(xs[q]);
                const float g0 = y0 * silu_f(bflo(z[q])), g1 = y1 * silu_f(bfhi(z[q]));
                v[jj][2 * q] = g0; v[jj][2 * q + 1] = g1; ss += g0 * g0 + g1 * g1;
            }
        }
        const float r = rsqrtf(wave_sum(ss) * (1.f / 2048) + EPS);
#pragma unroll
        for (int jj = 0; jj < 4; ++jj) {
            const int c = jj * 512 + lane * 8;
            const f32x4 g0 = *(const f32x4*)(ng + c), g1 = *(const f32x4*)(ng + c + 4);
            u32x4 o;
            o.x = pk2(v[jj][0] * r * g0[0], v[jj][1] * r * g0[1]); o.y = pk2(v[jj][2] * r * g0[2], v[jj][3] * r * g0[3]);
            o.z = pk2(v[jj][4] * r * g1[0], v[jj][5] * r * g1[1]); o.w = pk2(v[jj][6] * r * g1[2], v[jj][7] * r * g1[3]);
            *(u32x4*)(YN + (size_t)tok * 2048 + c) = o;
        }
    }
}

#ifndef PHASE_MASK
#define PHASE_MASK 0xFFFF
#endif
#define EN(x) (((PHASE_MASK) >> (x)) & 1)
constexpr int N_PHASES = 50;

__device__ __forceinline__ void run_phase(const Params& p, int ph, unsigned char* smem) {
    size_t zoff = 0; asm volatile("" : "+s"(zoff));
    unsigned char* ws = p.ws + zoff;
    float* X = (float*)(ws + WS_X);
    bf16_t* H = (bf16_t*)(ws + WS_H);
    bf16_t* U = (bf16_t*)(ws + WS_U);
    if (ph == 0) { if (EN(0)) phase0(p, smem); return; }
    if (ph == N_PHASES - 1) { if (EN(2)) phase_final(X, p.in[25], p.out + OUT_Y); return; }
    const int layer = (ph - 1) / 12, s = (ph - 1) % 12, j = layer >> 1;
    const bool is_mla = (layer & 1) == 0;
    const float* modl = (const float*)(ws + WS_MOD) + (size_t)layer * 3 * NMODC;
    if (s == 0 || s == 3 || s == 9) {
        const int ni = s == 0 ? 0 : (s == 3 ? 1 : 2);
        if (EN(1)) phase_norm(ph == 1 ? p.in[0] : X, ph == 1 ? p.in[1] : X, ph == 1 ? 4096 : 0, p.in[8] + (size_t)(layer * 3 + ni) * D, modl, ni * 3, ni * 3 + 1, H);
        return;
    }
    if (s == 1 || s == 10) {
        const int f = s == 1 ? 0 : 1;
        Epi8SwiGLU e{U};
        pg8::StaticOrder so; so.init(NTOK, 5632, gridDim.x, bid_opaque());
        if (EN(3)) pg8::gemm_phase((PG8_LAS unsigned char*)smem, H, (const bf16_t*)(ws + WS_W1T) + (size_t)(layer * 2 + f) * 5632 * 1024, 1024, so, e);
        return;
    }
    if (s == 2 || s == 11 || s == 8) {
        const bf16_t* A; const bf16_t* Bt; int K; int chunk; float sc;
        if (s == 2 || s == 11) { const int f = s == 2 ? 0 : 1; A = U; K = DFF; Bt = (const bf16_t*)(ws + WS_W2T) + (size_t)(layer * 2 + f) * 1024 * 2816; chunk = s == 2 ? 2 : 8; sc = 0.5f; }
        else if (is_mla) { A = (const bf16_t*)(ws + WS_O); K = 1024; Bt = (const bf16_t*)(ws + WS_MWO) + (size_t)j * 1024 * 1024; chunk = 5; sc = 1.f; }
        else { A = (const bf16_t*)(ws + WS_YN); K = 2048; Bt = (const bf16_t*)(ws + WS_SWOUT) + (size_t)j * 1024 * 2048; chunk = 5; sc = 1.f; }
        const bool firstres = ph == 3;
        EpiResid e{X, modl + chunk * 1024, sc, firstres ? p.in[0] : (const float*)X, firstres ? p.in[1] : (const float*)X, firstres ? 4096 : 0};
        if (EN(4)) gemm_tiles(A, K, Bt, K, NTOK, 1024, K, e, smem, 0);
        return;
    }
    if (is_mla) {
        if (s == 4) {
            EpiF32 e{(float*)(ws + WS_QKVA), 800, 800};
            if (EN(5)) gemm_tiles(H, D, (const bf16_t*)(ws + WS_MWIN) + (size_t)j * MLA_NPAD * 1024, 1024, NTOK, MLA_NPAD, 1024, e, smem, 0);
        } else if (s == 5) {
            if (EN(6)) phase_mlanorm((const float*)(ws + WS_QKVA), p.in[12] + j * 512, p.in[13] + j * 256, p.in[2], j, (const float*)(ws + WS_ROPE),
                          (bf16_t*)(ws + WS_QA), (bf16_t*)(ws + WS_CKV), (bf16_t*)(ws + WS_KR), p.out + OUT_CACHE);
        } else if (s == 6) {
            EpiQ eq{(bf16_t*)(ws + WS_Q), (const float*)(ws + WS_ROPE), 0.14724444f  };
            if (EN(7)) gemm_tiles((const bf16_t*)(ws + WS_QA), 512, (const bf16_t*)(ws + WS_MWQB) + (size_t)j * 1536 * 512, 512, NTOK, 1536, 512, eq, smem, 0);
            {
                EpiBf16 e{(bf16_t*)(ws + WS_KN), 1024};
                if (EN(7)) gemm_tiles((const bf16_t*)(ws + WS_CKV), 256, (const bf16_t*)(ws + WS_MWKN) + (size_t)j * 1024 * 256, 256, NTOKKV, 1024, 256, e, smem, 128);
            }
            {
                EpiBf16T e{(bf16_t*)(ws + WS_VT), NTOKKV};
                if (EN(7)) gemm_tiles((const bf16_t*)(ws + WS_MWV) + (size_t)j * 1024 * 256, 256, (const bf16_t*)(ws + WS_CKV), 256, 1024, NTOKKV, 256, e, smem, 144);
            }
        } else if (s == 7) {
            if (EN(8)) phase_attn((const bf16_t*)(ws + WS_Q), (const bf16_t*)(ws + WS_KN), (const bf16_t*)(ws + WS_KR), (const bf16_t*)(ws + WS_VT), (bf16_t*)(ws + WS_O), smem);
        }
    } else {
        if (s == 4) {
            Epi8SSMIn e{(bf16_t*)(ws + WS_ZXB), (float*)(ws + WS_DTRAW)};
            pg8::StaticOrder so; so.init(NTOK, SSM_NPAD, gridDim.x, bid_opaque());
            if (EN(9)) pg8::gemm_phase((PG8_LAS unsigned char*)smem, H, (const bf16_t*)(ws + WS_SWIN) + (size_t)j * SSM_NPAD * 1024, 1024, so, e);
        } else if (s == 5) {
            if (EN(10)) phase_conv((const bf16_t*)(ws + WS_ZXB), (const float*)(ws + WS_DTRAW), p.in[18] + (size_t)j * 5 * 3072, p.in[19] + j * 3072, p.in[20] + j * 64,
                       (bf16_t*)(ws + WS_XS), (bf16_t*)(ws + WS_XT), (bf16_t*)(ws + WS_BM), (bf16_t*)(ws + WS_BT), (bf16_t*)(ws + WS_CM), (float*)(ws + WS_DT), smem);
        } else if (s == 6) {
            if (EN(11)) phase_ssd((const bf16_t*)(ws + WS_XT), (const bf16_t*)(ws + WS_BM), (const bf16_t*)(ws + WS_BT), (const bf16_t*)(ws + WS_CM), (const float*)(ws + WS_DT),
                      p.in[21] + j * 64, p.in[3], j, (bf16_t*)(ws + WS_YF), (bf16_t*)(ws + WS_YB), p.out + OUT_STATE, smem);
        } else if (s == 7) {
            if (EN(12)) phase_gnorm((const bf16_t*)(ws + WS_YF), (const bf16_t*)(ws + WS_YB), (const bf16_t*)(ws + WS_XS), (const bf16_t*)(ws + WS_ZXB), p.in[22] + j * 64, p.in[23] + j * 2048,
                        (bf16_t*)(ws + WS_YN));
        }
    }
}

#define XB_TMO      128
#define XB_XCNT(j)  (256  + 64 * (j))
#define XB_XSUB(j)  (1280 + 64 * (j))
#define XB_XGEN(j)  (2304 + 64 * (j))
#define XB_TOP      3328
#define XB_TOPGEN   3392
#define XCD_BAR_WORDS 3456
#define XB_SPIN_CAP (1u << 18)
#define LAS __attribute__((address_space(3)))

__device__ __forceinline__ unsigned xb_ld(unsigned* p)              { return __hip_atomic_load(p, __ATOMIC_RELAXED, __HIP_MEMORY_SCOPE_AGENT); }
__device__ __forceinline__ unsigned xb_add(unsigned* p, unsigned v) { return __hip_atomic_fetch_add(p, v, __ATOMIC_RELAXED, __HIP_MEMORY_SCOPE_AGENT); }
__device__ __forceinline__ unsigned xb_xcc_id() { return (unsigned)__builtin_amdgcn_s_getreg((3 << 11) | 20) & 0xFu; }
#define XB_SPIN(cond, bar) do { unsigned _sp = 0; while (cond) { __builtin_amdgcn_s_sleep(1); \
    if ((++_sp & 255u) == 0u) { if (xb_ld(&(bar)[XB_TMO])) break; if (_sp > XB_SPIN_CAP) { atomicAdd(&(bar)[XB_TMO], 1u); break; } } } } while (0)

struct XcdBarrier {
    unsigned* bar; unsigned x;
    volatile LAS unsigned* st;
};

__device__ __forceinline__ XcdBarrier xcd_barrier_post(unsigned* bar, volatile LAS unsigned* st) {
    XcdBarrier b; b.bar = bar; b.x = xb_xcc_id(); b.st = st;
    if (threadIdx.x == 0) (void)xb_add(&bar[XB_XCNT(b.x)], 1u);
    return b;
}
__device__ __forceinline__ void xcd_barrier_complete(unsigned* bar, unsigned x, unsigned& nloc, unsigned& nx) {
    const unsigned G = gridDim.x * gridDim.y * gridDim.z;
    unsigned sum, cnt, mine, sp = 0u;
    for (;;) {
        sum = 0u; cnt = 0u; mine = 0u;
#pragma unroll
        for (unsigned j = 0; j < 16; ++j) { const unsigned c = xb_ld(&bar[XB_XCNT(j)]); sum += c; cnt += (c > 0u) ? 1u : 0u; mine = (j == x) ? c : mine; }
        if (sum == G) break;
        __builtin_amdgcn_s_sleep(1);
        if ((++sp & 255u) == 0u) { if (xb_ld(&bar[XB_TMO])) break; if (sp > XB_SPIN_CAP) { atomicAdd(&bar[XB_TMO], 1u); break; } }
    }
    nloc = mine > 0u ? mine : 1u; nx = cnt > 0u ? cnt : 1u;
}

__device__ __forceinline__ void xcd_barrier(const XcdBarrier& b) {
    asm volatile("s_waitcnt vmcnt(0)" ::: "memory");
    __syncthreads();
    if (threadIdx.x == 0) {
        unsigned* bar = b.bar;
        __builtin_amdgcn_s_waitcnt(0);
        unsigned nloc = b.st[0], nx = b.st[1];
        if (nloc == 0u) { xcd_barrier_complete(bar, b.x, nloc, nx); b.st[0] = nloc; b.st[1] = nx; }
        const unsigned old = xb_add(&bar[XB_XSUB(b.x)], 1u);
        const unsigned gen = old / nloc;
        if (old + 1u == (gen + 1u) * nloc) {
            __builtin_amdgcn_fence(__ATOMIC_RELEASE, "agent");
            asm volatile("s_waitcnt vmcnt(0)" ::: "memory");
            const unsigned og = xb_add(&bar[XB_TOP], 1u);
            const unsigned tg = og / nx;
            if (og + 1u == (tg + 1u) * nx) xb_add(&bar[XB_TOPGEN], 1u);
            else XB_SPIN(xb_ld(&bar[XB_TOPGEN]) == tg, bar);
            __builtin_amdgcn_fence(__ATOMIC_ACQUIRE, "agent");
            xb_add(&bar[XB_XGEN(b.x)], 1u);
            asm volatile("s_waitcnt vmcnt(0)" ::: "memory");
        } else {
            XB_SPIN(xb_ld(&bar[XB_XGEN(b.x)]) == gen, bar);
            __builtin_amdgcn_fence(__ATOMIC_ACQUIRE, "agent");
            asm volatile("s_waitcnt vmcnt(0)" ::: "memory");
        }
    }
    __syncthreads();
}

__device__ __forceinline__ void grid_barrier(unsigned* ctr, unsigned target) {
    __syncthreads();
    if (threadIdx.x == 0) {
        __threadfence();
        __hip_atomic_fetch_add(ctr, 1u, __ATOMIC_RELAXED, __HIP_MEMORY_SCOPE_AGENT);
        while (__hip_atomic_load(ctr, __ATOMIC_RELAXED, __HIP_MEMORY_SCOPE_AGENT) < target) __builtin_amdgcn_s_sleep(1);
        __threadfence();
    }
    __syncthreads();
}

__global__ void __launch_bounds__(NT) mega_fwd(Params p) {
    extern __shared__ __attribute__((aligned(16))) unsigned char smem[];
    cg::grid_group grid = cg::this_grid();
    volatile LAS unsigned* xst = (volatile LAS unsigned*)(smem + LDS_BYTES - 16);
    if (threadIdx.x == 0) { xst[0] = 0u; xst[1] = 0u; }
    __syncthreads();
    XcdBarrier xb = xcd_barrier_post((unsigned*)(p.ws + WS_BAR), xst);
    for (int ph = p.ph_lo; ph < p.ph_hi; ++ph) {
        if (ph > p.ph_lo) { if (ph == 1) grid.sync(); else xcd_barrier(xb); }
        run_phase(p, ph, smem);
    }
}

extern "C" void kernel_launch(void* const* d_in, const int* in_sizes, int n_in, void* d_out, int out_size, void* d_ws, size_t ws_size, hipStream_t stream) {
    static int grid_blocks = 0;
    if (grid_blocks == 0) {
        if (n_in != 26 || ws_size < WS_END) { fprintf(stderr, "kernel_launch: unexpected n_in %d / ws_size %zu (need %zu)\n", n_in, ws_size, (size_t)WS_END); grid_blocks = -1; return; }
        int dev = 0, cus = 0, per_cu = 0;
        (void)hipGetDevice(&dev);
        (void)hipDeviceGetAttribute(&cus, hipDeviceAttributeMultiprocessorCount, dev);
        if (hipFuncSetAttribute((const void*)mega_fwd, hipFuncAttributeMaxDynamicSharedMemorySize, LDS_BYTES) != hipSuccess) { fprintf(stderr, "kernel_launch: hipFuncSetAttribute failed\n"); }
        if (hipOccupancyMaxActiveBlocksPerMultiprocessor(&per_cu, (const void*)mega_fwd, NT, LDS_BYTES) != hipSuccess || per_cu < 1) { fprintf(stderr, "kernel_launch: occupancy query says %d\n", per_cu); per_cu = 1; }
        (void)hipGetLastError();
        grid_blocks = cus * 1;
        if (grid_blocks <= 0) grid_blocks = 256;
    }
    if (grid_blocks < 0) return;
    Params p;
    memset(&p, 0, sizeof(p));
    for (int i = 0; i < 26; ++i) p.in[i] = (const float*)d_in[i];
    p.out = (float*)d_out; p.ws = (unsigned char*)d_ws;
#if N_LAUNCH_MODE == 1
    (void)hipMemsetAsync((unsigned char*)d_ws + WS_BAR, 0, 16384, stream);
    p.ph_lo = 0; p.ph_hi = N_PHASES;
    void* args[] = {&p};
    hipError_t e = hipLaunchCooperativeKernel((const void*)mega_fwd, dim3(grid_blocks), dim3(NT), args, LDS_BYTES, stream);
    if (e != hipSuccess) fprintf(stderr, "cooperative launch failed: %s (grid %d)\n", hipGetErrorString(e), grid_blocks);
#else
    for (int ph = 0; ph < N_PHASES; ++ph) {
#ifdef PH_LIMIT
        if (ph >= PH_LIMIT && ph != N_PHASES - 1) continue;
#endif
        p.ph_lo = ph; p.ph_hi = ph + 1;
        hipLaunchKernelGGL(mega_fwd, dim3(grid_blocks), dim3(NT), LDS_BYTES, stream, p);
    }
#endif
}
```

```cpp
#include <hip/hip_runtime.h>
#include <hip/hip_cooperative_groups.h>
#include <cstdio>
#include <cstring>
namespace cg = cooperative_groups;

#ifndef N_LAUNCH_MODE
#define N_LAUNCH_MODE 1
#endif

typedef unsigned short bf16_t;
typedef short bf16x8 __attribute__((ext_vector_type(8)));
typedef float f32x4 __attribute__((ext_vector_type(4)));
typedef unsigned u32x2 __attribute__((ext_vector_type(2)));
typedef unsigned u32x4 __attribute__((ext_vector_type(4)));

constexpr int NT = 512;
constexpr int NTOK = 8192;
constexpr int NTOKKV = 8704;
constexpr int D = 1024, DFF = 2816, NMODC = 9216;
constexpr int SSM_NPAD = 5376;
constexpr int MLA_NPAD = 896;
constexpr float EPS = 1e-6f;

constexpr size_t al256(size_t x) { return (x + 255) & ~(size_t)255; }
constexpr size_t WS_X = 0;
constexpr size_t WS_H = WS_X + al256((size_t)NTOK * D * 4);
constexpr size_t WS_U = WS_H + al256((size_t)NTOK * D * 2);
constexpr size_t WS_MOD = WS_U + al256((size_t)NTOK * DFF * 2);
constexpr size_t WS_ROPE = WS_MOD + al256((size_t)4 * 3 * NMODC * 4);
constexpr size_t WS_W1T = WS_ROPE + al256((size_t)2048 * 32 * 4);
constexpr size_t WS_W2T = WS_W1T + al256((size_t)8 * 5632 * 1024 * 2);
constexpr size_t WS_MWIN = WS_W2T + al256((size_t)8 * 1024 * 2816 * 2);
constexpr size_t WS_MWQB = WS_MWIN + al256((size_t)2 * MLA_NPAD * 1024 * 2);
constexpr size_t WS_MWKN = WS_MWQB + al256((size_t)2 * 1536 * 512 * 2);
constexpr size_t WS_MWV = WS_MWKN + al256((size_t)2 * 1024 * 256 * 2);
constexpr size_t WS_MWO = WS_MWV + al256((size_t)2 * 1024 * 256 * 2);
constexpr size_t WS_SWIN = WS_MWO + al256((size_t)2 * 1024 * 1024 * 2);
constexpr size_t WS_SWOUT = WS_SWIN + al256((size_t)2 * SSM_NPAD * 1024 * 2);
constexpr size_t WS_TMP = WS_SWOUT + al256((size_t)2 * 1024 * 2048 * 2);
constexpr size_t WS_QKVA = WS_TMP;
constexpr size_t WS_QA = WS_QKVA + al256((size_t)NTOK * 800 * 4);
constexpr size_t WS_CKV = WS_QA + al256((size_t)NTOK * 512 * 2);
constexpr size_t WS_KR = WS_CKV + al256((size_t)NTOKKV * 256 * 2);
constexpr size_t WS_Q = WS_KR + al256((size_t)NTOKKV * 32 * 2);
constexpr size_t WS_KN = WS_Q + al256((size_t)NTOK * 1536 * 2);
constexpr size_t WS_VT = WS_KN + al256((size_t)NTOKKV * 1024 * 2);
constexpr size_t WS_O = WS_VT + al256((size_t)1024 * NTOKKV * 2);
constexpr size_t WS_MLA_END = WS_O + al256((size_t)NTOK * 1024 * 2);
constexpr size_t WS_ZXB = WS_TMP;
constexpr size_t WS_DTRAW = WS_ZXB + al256((size_t)NTOK * 5120 * 2);
constexpr size_t WS_XS = WS_DTRAW + al256((size_t)NTOK * 64 * 4);
constexpr size_t WS_XT = WS_XS + al256((size_t)NTOK * 2048 * 2);
constexpr size_t WS_BM = WS_XT + al256((size_t)NTOK * 2048 * 2);
constexpr size_t WS_BT = WS_BM + al256((size_t)NTOK * 512 * 2);
constexpr size_t WS_CM = WS_BT + al256((size_t)NTOK * 512 * 2);
constexpr size_t WS_DT = WS_CM + al256((size_t)NTOK * 512 * 2);
constexpr size_t WS_YF = WS_DT + al256((size_t)NTOK * 64 * 4);
constexpr size_t WS_YB = WS_YF + al256((size_t)NTOK * 2048 * 2);
constexpr size_t WS_YN = WS_YB + al256((size_t)NTOK * 2048 * 2);
constexpr size_t WS_SSM_END = WS_YN + al256((size_t)NTOK * 2048 * 2);
constexpr size_t WS_P = WS_SSM_END > WS_MLA_END ? WS_SSM_END : WS_MLA_END;
constexpr size_t WS_BAR = WS_P + al256((size_t)NTOK * D * 2);
constexpr size_t WS_END = WS_BAR + 16384;

constexpr size_t OUT_Y = 0;
constexpr size_t OUT_CACHE = (size_t)NTOK * D;
constexpr size_t OUT_STATE = OUT_CACHE + (size_t)16 * 2 * 256 * 288;

constexpr int LDS_BYTES = 141312;

struct Params {
    const float* in[26];
    float* out;
    unsigned char* ws;
    int ph_lo, ph_hi;
};

typedef __bf16 bf16v2_t __attribute__((ext_vector_type(2)));
typedef float f32v2_t __attribute__((ext_vector_type(2)));
__device__ __forceinline__ unsigned pk2(float lo, float hi) { f32v2_t f = {lo, hi}; bf16v2_t b = __builtin_convertvector(f, bf16v2_t); return __builtin_bit_cast(unsigned, b); }
__device__ __forceinline__ bf16_t f2bf(float f) { return (bf16_t)(pk2(f, 0.f) & 0xffffu); }
__device__ __forceinline__ float bflo(unsigned u) { return __uint_as_float(u << 16); }
__device__ __forceinline__ float bfhi(unsigned u) { return __uint_as_float(u & 0xffff0000u); }
__device__ __forceinline__ float silu_f(float x) { return x / (1.f + __expf(-x)); }
__device__ __forceinline__ float wave_sum(float v) {
#pragma unroll
    for (int o = 32; o > 0; o >>= 1) v += __shfl_xor(v, o);
    return v;
}
__device__ __forceinline__ u32x2 pack4(f32x4 v) { u32x2 r; r.x = pk2(v[0], v[1]); r.y = pk2(v[2], v[3]); return r; }
__device__ __forceinline__ f32x4 mfma16(bf16x8 a, bf16x8 b, f32x4 c) { return __builtin_amdgcn_mfma_f32_16x16x32_bf16(a, b, c, 0, 0, 0); }
__device__ __forceinline__ int modrow(int tok) { return tok < 4096 ? 0 : 1 + ((tok - 4096) >> 11); }

__device__ __forceinline__ int tid_opaque() { int t = threadIdx.x; asm volatile("" : "+v"(t)); return t; }
__device__ __forceinline__ int bid_opaque() { int t = blockIdx.x; asm volatile("" : "+s"(t)); return t; }
__device__ __forceinline__ void conv_tile(const float* __restrict__ src, int ldsrc, int nvalid, int mode, bf16_t* __restrict__ dst, int K, int n0, int k0, bf16_t* tile) {
    const int tid = tid_opaque();
    {
        const int nn = tid & 63, kr = tid >> 6, n = n0 + nn;
        int col; bool valid = true;
        if (mode == 0) { col = n; valid = n < nvalid; }
        else if (mode == 1) { const int q = n >> 8, w = n & 255; col = (w < 128) ? (q * 128 + w) : (DFF + q * 128 + (w - 128)); }
        else if (mode == 2) { col = (n >> 6) * 128 + (n & 63); }
        else { col = (n >> 6) * 128 + 64 + (n & 63); }
        const float* s = src + (size_t)(k0 + kr) * ldsrc + col;
#pragma unroll
        for (int ps = 0; ps < 8; ++ps) {
            const float v = valid ? __builtin_nontemporal_load(s + (size_t)(ps * 8) * ldsrc) : 0.f;
            tile[nn * 66 + ps * 8 + kr] = f2bf(v);
        }
    }
    __syncthreads();
    {
        const int nn = tid >> 3, ch = tid & 7;
        const unsigned* t32 = (const unsigned*)tile + nn * 33 + ch * 4;
        u32x4 o; o.x = t32[0]; o.y = t32[1]; o.z = t32[2]; o.w = t32[3];
        *(u32x4*)(dst + (size_t)(n0 + nn) * K + k0 + ch * 8) = o;
    }
    __syncthreads();
}

__device__ __forceinline__ void phase0(const Params& p, unsigned char* smem) {
    const int tid = tid_opaque(), G = gridDim.x, b = bid_opaque();
    float* X = (float*)(p.ws + WS_X);
    {
        const f32x4* xp = (const f32x4*)p.in[0]; const f32x4* xs = (const f32x4*)p.in[1]; f32x4* xo = (f32x4*)X;
        const int n4 = NTOK * D / 4, half = n4 / 2;
        for (int i = b * NT + tid; i < n4; i += G * NT) xo[i] = i < half ? xp[i] : xs[i - half];
    }
    {
        float* rope = (float*)(p.ws + WS_ROPE);
        for (int i = b * NT + tid; i < 2048 * 16; i += G * NT) {
            const int pos = i >> 4, a = (i >> 3) & 1, f = i & 7;
            const double position = a == 0 ? (double)(pos >> 6) : (double)(pos & 63);
            double freq = (f & 1) ? 0.31622776601683794 : 1.0;
            const int f2 = f >> 1; if (f2 == 1) freq *= 0.1; else if (f2 == 2) freq *= 0.01; else if (f2 == 3) freq *= 0.001;
            const double ang = position * freq;
            const double kq = rint(ang * 0.63661977236758134);
            const double r = ang - kq * 1.5707963267948966;
            const double r2 = r * r;
            double sn = r * (1.0 + r2 * (-1.0 / 6 + r2 * (1.0 / 120 + r2 * (-1.0 / 5040 + r2 * (1.0 / 362880 + r2 * (-1.0 / 39916800 + r2 * (1.0 / 6227020800.0 + r2 * (-1.0 / 1307674368000.0))))))));
            double cs = 1.0 + r2 * (-0.5 + r2 * (1.0 / 24 + r2 * (-1.0 / 720 + r2 * (1.0 / 40320 + r2 * (-1.0 / 3628800 + r2 * (1.0 / 479001600.0 + r2 * (-1.0 / 87178291200.0 + r2 * (1.0 / 20922789888000.0))))))));
            const int q = ((int)kq) & 3;
            double c, s;
            if (q == 0) { c = cs; s = sn; } else if (q == 1) { c = -sn; s = cs; } else if (q == 2) { c = -cs; s = -sn; } else { c = sn; s = -cs; }
            rope[pos * 32 + a * 8 + f] = (float)c;
            rope[pos * 32 + 16 + a * 8 + f] = (float)s;
        }
    }
    {
        float* sc = (float*)smem; float* red = sc + 3072;
        const float* cin = p.in[4]; const float* cctx = p.in[5];
        for (int i = tid; i < 3072; i += NT) { const int row = i >> 10, k = i & 1023; const float c = row == 0 ? cctx[k] : cin[(row - 1) * 1024 + k]; sc[i] = silu_f(c); }
        __syncthreads();
        float* MOD = (float*)(p.ws + WS_MOD);
        for (int item = b; item < 4 * 288; item += G) {
            const int layer = item / 288, col0 = (item % 288) * 32;
            const int cq = tid & 7, ks = tid >> 3;
            const float* w = p.in[6] + (size_t)layer * 1024 * NMODC + (size_t)(ks * 16) * NMODC + col0 + cq * 4;
            f32x4 a0 = {0.f, 0.f, 0.f, 0.f}, a1 = a0, a2 = a0;
            f32x4 wv[16];
#pragma unroll
            for (int kk = 0; kk < 16; ++kk) wv[kk] = __builtin_nontemporal_load((const f32x4*)(w + (size_t)kk * NMODC));
            asm volatile("" ::: "memory");
#pragma unroll
            for (int kk = 0; kk < 16; ++kk) {
                const int k = ks * 16 + kk;
                a0 += sc[k] * wv[kk]; a1 += sc[1024 + k] * wv[kk]; a2 += sc[2048 + k] * wv[kk];
            }
            *(f32x4*)(red + ks * 96 + cq * 4) = a0; *(f32x4*)(red + ks * 96 + 32 + cq * 4) = a1; *(f32x4*)(red + ks * 96 + 64 + cq * 4) = a2;
            __syncthreads();
            if (tid < 96) {
                float s = 0.f;
                for (int k2 = 0; k2 < 64; ++k2) s += red[k2 * 96 + tid];
                const int row = tid >> 5, c = tid & 31;
                MOD[(size_t)(layer * 3 + row) * NMODC + col0 + c] = s + p.in[7][(size_t)layer * NMODC + col0 + c];
            }
            __syncthreads();
        }
    }
    {
        bf16_t* tile = (bf16_t*)smem;
        constexpr int T_W1 = 88 * 16, T_W2 = 16 * 44, T_MIN = 14 * 16, T_MQB = 24 * 8, T_MKV = 16 * 4, T_MO = 16 * 16, T_SIN = 84 * 16, T_SOUT = 16 * 32;
        constexpr int TOTAL = 8 * T_W1 + 8 * T_W2 + 2 * (T_MIN + T_MQB + 2 * T_MKV + T_MO) + 2 * (T_SIN + T_SOUT);
        const int nn = tid & 63, kr = tid >> 6, on = tid >> 3, och = tid & 7;
        for (int t0 = b; t0 < TOTAL; t0 += 4 * G) {
            float v[4][8];
            bf16_t* dsts[4];
#pragma unroll
            for (int u = 0; u < 4; ++u) {
                int r = t0 + u * G;
                const bool live = r < TOTAL;
                if (!live) r = 0;
                const float* src; bf16_t* dst; int K, ld, nvalid, mode;
                if (r < 8 * T_W1) { const int j = r / T_W1; r -= j * T_W1; src = p.in[9] + (size_t)j * 1024 * 5632; dst = (bf16_t*)(p.ws + WS_W1T) + (size_t)j * 5632 * 1024; K = 1024; ld = 5632; nvalid = 5632; mode = 1; }
                else if ((r -= 8 * T_W1) < 8 * T_W2) { const int j = r / T_W2; r -= j * T_W2; src = p.in[10] + (size_t)j * 2816 * 1024; dst = (bf16_t*)(p.ws + WS_W2T) + (size_t)j * 1024 * 2816; K = 2816; ld = 1024; nvalid = 1024; mode = 0; }
                else if ((r -= 8 * T_W2) < 2 * T_MIN) { const int j = r / T_MIN; r -= j * T_MIN; src = p.in[11] + (size_t)j * 1024 * 800; dst = (bf16_t*)(p.ws + WS_MWIN) + (size_t)j * MLA_NPAD * 1024; K = 1024; ld = 800; nvalid = 800; mode = 0; }
                else if ((r -= 2 * T_MIN) < 2 * T_MQB) { const int j = r / T_MQB; r -= j * T_MQB; src = p.in[14] + (size_t)j * 512 * 1536; dst = (bf16_t*)(p.ws + WS_MWQB) + (size_t)j * 1536 * 512; K = 512; ld = 1536; nvalid = 1536; mode = 0; }
                else if ((r -= 2 * T_MQB) < 2 * T_MKV) { const int j = r / T_MKV; r -= j * T_MKV; src = p.in[15] + (size_t)j * 256 * 2048; dst = (bf16_t*)(p.ws + WS_MWKN) + (size_t)j * 1024 * 256; K = 256; ld = 2048; nvalid = 1024; mode = 2; }
                else if ((r -= 2 * T_MKV) < 2 * T_MKV) { const int j = r / T_MKV; r -= j * T_MKV; src = p.in[15] + (size_t)j * 256 * 2048; dst = (bf16_t*)(p.ws + WS_MWV) + (size_t)j * 1024 * 256; K = 256; ld = 2048; nvalid = 1024; mode = 3; }
                else if ((r -= 2 * T_MKV) < 2 * T_MO) { const int j = r / T_MO; r -= j * T_MO; src = p.in[16] + (size_t)j * 1024 * 1024; dst = (bf16_t*)(p.ws + WS_MWO) + (size_t)j * 1024 * 1024; K = 1024; ld = 1024; nvalid = 1024; mode = 0; }
                else if ((r -= 2 * T_MO) < 2 * T_SIN) { const int j = r / T_SIN; r -= j * T_SIN; src = p.in[17] + (size_t)j * 1024 * 5184; dst = (bf16_t*)(p.ws + WS_SWIN) + (size_t)j * SSM_NPAD * 1024; K = 1024; ld = 5184; nvalid = 5184; mode = 0; }
                else { r -= 2 * T_SIN; const int j = r / T_SOUT; r -= j * T_SOUT; src = p.in[24] + (size_t)j * 2048 * 1024; dst = (bf16_t*)(p.ws + WS_SWOUT) + (size_t)j * 1024 * 2048; K = 2048; ld = 1024; nvalid = 1024; mode = 0; }
                const int nkt = K >> 6, n0 = (r / nkt) * 64, k0 = (r % nkt) * 64, n = n0 + nn;
                int col; bool valid = live;
                if (mode == 0) { col = n; valid = valid && n < nvalid; }
                else if (mode == 1) { const int q = n >> 8, w = n & 255; col = (w < 128) ? (q * 128 + w) : (DFF + q * 128 + (w - 128)); }
                else if (mode == 2) { col = (n >> 6) * 128 + (n & 63); }
                else { col = (n >> 6) * 128 + 64 + (n & 63); }
                const float* sp = src + (size_t)(k0 + kr) * ld + (valid ? col : 0);
#pragma unroll
                for (int ps = 0; ps < 8; ++ps) { const float x = __builtin_nontemporal_load(sp + (size_t)(ps * 8) * ld); v[u][ps] = valid ? x : 0.f; }
                dsts[u] = live ? dst + (size_t)(n0 + on) * K + k0 + och * 8 : nullptr;
            }
#pragma unroll
            for (int u = 0; u < 4; ++u)
#pragma unroll
                for (int ps = 0; ps < 8; ++ps) tile[u * 4224 + nn * 66 + ps * 8 + kr] = f2bf(v[u][ps]);
            __syncthreads();
#pragma unroll
            for (int u = 0; u < 4; ++u) {
                const unsigned* t32 = (const unsigned*)(tile + u * 4224) + on * 33 + och * 4;
                u32x4 o; o.x = t32[0]; o.y = t32[1]; o.z = t32[2]; o.w = t32[3];
                if (dsts[u]) *(u32x4*)dsts[u] = o;
            }
            __syncthreads();
        }
    }
}

__device__ __forceinline__ void phase_norm(float* X, const bf16_t* P, const float* __restrict__ g, const float* __restrict__ modl, int shift_chunk, int scale_chunk, bf16_t* __restrict__ H) {
    const int tid_ = tid_opaque(); const int lane = tid_ & 63, gw = bid_opaque() * 8 + (tid_ >> 6), nW = gridDim.x * 8;
#pragma unroll 4
    for (int tok = gw; tok < NTOK; tok += nW) {
        float* xr = X + (size_t)tok * D + lane * 4;
        f32x4 v[4]; float ss = 0.f;
#pragma unroll
        for (int j = 0; j < 4; ++j) v[j] = *(const f32x4*)(xr + 256 * j);
        if (P) {
            u32x2 pv[4];
#pragma unroll
            for (int j = 0; j < 4; ++j) pv[j] = *(const u32x2*)(P + (size_t)tok * D + lane * 4 + 256 * j);
#pragma unroll
            for (int j = 0; j < 4; ++j) { v[j][0] += bflo(pv[j].x); v[j][1] += bfhi(pv[j].x); v[j][2] += bflo(pv[j].y); v[j][3] += bfhi(pv[j].y); *(f32x4*)(xr + 256 * j) = v[j]; }
        }
#pragma unroll
        for (int j = 0; j < 4; ++j) ss += v[j][0] * v[j][0] + v[j][1] * v[j][1] + v[j][2] * v[j][2] + v[j][3] * v[j][3];
        const float r = rsqrtf(wave_sum(ss) * (1.f / D) + EPS);
        const float* mr = modl + (size_t)modrow(tok) * NMODC;
#pragma unroll
        for (int j = 0; j < 4; ++j) {
            const int k = lane * 4 + 256 * j;
            const f32x4 gv = *(const f32x4*)(g + k), sc = *(const f32x4*)(mr + scale_chunk * 1024 + k), sh = *(const f32x4*)(mr + shift_chunk * 1024 + k);
            f32x4 h;
#pragma unroll
            for (int e = 0; e < 4; ++e) h[e] = v[j][e] * r * gv[e] * (1.f + sc[e]) + sh[e];
            *(u32x2*)(H + (size_t)tok * D + k) = pack4(h);
        }
    }
}
__device__ __forceinline__ void phase_final(const float* __restrict__ X, const bf16_t* __restrict__ P, const float* __restrict__ g, float* __restrict__ out) {
    const int tid_ = tid_opaque(); const int lane = tid_ & 63, gw = bid_opaque() * 8 + (tid_ >> 6), nW = gridDim.x * 8;
#pragma unroll 4
    for (int tok = gw; tok < NTOK; tok += nW) {
        const float* xr = X + (size_t)tok * D + lane * 4;
        f32x4 v[4]; float ss = 0.f;
#pragma unroll
        for (int j = 0; j < 4; ++j) { v[j] = *(const f32x4*)(xr + 256 * j); const u32x2 pv = *(const u32x2*)(P + (size_t)tok * D + lane * 4 + 256 * j);
            v[j][0] += bflo(pv.x); v[j][1] += bfhi(pv.x); v[j][2] += bflo(pv.y); v[j][3] += bfhi(pv.y);
            ss += v[j][0] * v[j][0] + v[j][1] * v[j][1] + v[j][2] * v[j][2] + v[j][3] * v[j][3]; }
        const float r = rsqrtf(wave_sum(ss) * (1.f / D) + EPS);
#pragma unroll
        for (int j = 0; j < 4; ++j) {
            const int k = lane * 4 + 256 * j;
            const f32x4 gv = *(const f32x4*)(g + k);
            f32x4 h;
#pragma unroll
            for (int e = 0; e < 4; ++e) h[e] = v[j][e] * r * gv[e];
            *(f32x4*)(out + (size_t)tok * D + k) = h;
        }
    }
}

struct EpiSwiGLU {
    bf16_t* U;
    __device__ __forceinline__ void operator()(f32x4 (&acc)[4][4], int row0, int col0, int fr, int fq) const {
        const int j0 = (col0 >> 6) * 32;
#pragma unroll
        for (int mt = 0; mt < 4; ++mt) {
            const int row = row0 + mt * 16 + fr;
#pragma unroll
            for (int h = 0; h < 2; ++h) {
                f32x4 o;
#pragma unroll
                for (int e = 0; e < 4; ++e) o[e] = silu_f(acc[mt][h][e]) * acc[mt][h + 2][e];
                *(u32x2*)(U + (size_t)row * DFF + j0 + h * 16 + fq * 4) = pack4(o);
            }
        }
    }
};
struct EpiResid {
    float* X; const float* gate; float s;
    __device__ __forceinline__ void operator()(f32x4 (&acc)[4][4], int row0, int col0, int fr, int fq) const {
        const float* gr = gate + (size_t)modrow(row0) * NMODC + col0 + fq * 4;
        float* xp0 = X + (size_t)(row0 + fr) * D + col0 + fq * 4;
        f32x4 gv[4], x[4][4];
#pragma unroll
        for (int nt = 0; nt < 4; ++nt) gv[nt] = *(const f32x4*)(gr + nt * 16);
#pragma unroll
        for (int mt = 0; mt < 4; ++mt)
#pragma unroll
            for (int nt = 0; nt < 4; ++nt) x[mt][nt] = *(const f32x4*)(xp0 + (size_t)(mt * 16) * D + nt * 16);
        asm volatile("" ::: "memory");
#pragma unroll
        for (int mt = 0; mt < 4; ++mt)
#pragma unroll
            for (int nt = 0; nt < 4; ++nt) {
#pragma unroll
                for (int e = 0; e < 4; ++e) x[mt][nt][e] += s * gv[nt][e] * acc[mt][nt][e];
                *(f32x4*)(xp0 + (size_t)(mt * 16) * D + nt * 16) = x[mt][nt];
            }
    }
};
struct EpiF32 {
    float* C; int ldc, ncols;
    __device__ __forceinline__ void operator()(f32x4 (&acc)[4][4], int row0, int col0, int fr, int fq) const {
#pragma unroll
        for (int mt = 0; mt < 4; ++mt)
#pragma unroll
            for (int nt = 0; nt < 4; ++nt) {
                const int row = row0 + mt * 16 + fr, col = col0 + nt * 16 + fq * 4;
                if (col < ncols) *(f32x4*)(C + (size_t)row * ldc + col) = acc[mt][nt];
            }
    }
};
struct EpiBf16 {
    bf16_t* C; int ldc;
    __device__ __forceinline__ void operator()(f32x4 (&acc)[4][4], int row0, int col0, int fr, int fq) const {
#pragma unroll
        for (int mt = 0; mt < 4; ++mt)
#pragma unroll
            for (int nt = 0; nt < 4; ++nt) {
                const int row = row0 + mt * 16 + fr, col = col0 + nt * 16 + fq * 4;
                *(u32x2*)(C + (size_t)row * ldc + col) = pack4(acc[mt][nt]);
            }
    }
};
struct EpiBf16T {
    bf16_t* C; int ldc;
    __device__ __forceinline__ void operator()(f32x4 (&acc)[4][4], int row0, int col0, int fr, int fq) const {
#pragma unroll
        for (int mt = 0; mt < 4; ++mt)
#pragma unroll
            for (int nt = 0; nt < 4; ++nt) {
                const int row = row0 + mt * 16 + fr, col = col0 + nt * 16 + fq * 4;
                *(u32x2*)(C + (size_t)row * ldc + col) = pack4(acc[mt][nt]);
            }
    }
};
struct EpiSSMIn {
    bf16_t* ZXB; float* DTRAW;
    __device__ __forceinline__ void operator()(f32x4 (&acc)[4][4], int row0, int col0, int fr, int fq) const {
#pragma unroll
        for (int mt = 0; mt < 4; ++mt)
#pragma unroll
            for (int nt = 0; nt < 4; ++nt) {
                const int row = row0 + mt * 16 + fr, col = col0 + nt * 16 + fq * 4;
                if (col < 5120) *(u32x2*)(ZXB + (size_t)row * 5120 + col) = pack4(acc[mt][nt]);
                else if (col < 5184) *(f32x4*)(DTRAW + (size_t)row * 64 + (col - 5120)) = acc[mt][nt];
            }
    }
};
struct EpiQ {
    bf16_t* Q; const float* rope; float qscale;
    __device__ __forceinline__ void operator()(f32x4 (&acc)[4][4], int row0, int col0, int fr, int fq) const {
#pragma unroll
        for (int mt = 0; mt < 4; ++mt) {
            const int row = row0 + mt * 16 + fr;
            const int pos = (row - 4096) & 2047;
#pragma unroll
            for (int nt = 0; nt < 4; ++nt) {
                const int c16 = col0 + nt * 16, d16 = c16 % 96;
                f32x4 v = acc[mt][nt];
                if (row0 >= 4096 && d16 >= 64) {
                    const int axis = (d16 - 64) >> 4, ph = fq >> 1, f0 = (fq & 1) * 4;
                    f32x4 pr;
#pragma unroll
                    for (int e = 0; e < 4; ++e) pr[e] = __shfl_xor(v[e], 32);
                    const f32x4 cs = *(const f32x4*)(rope + pos * 32 + axis * 8 + f0), sn = *(const f32x4*)(rope + pos * 32 + 16 + axis * 8 + f0);
#pragma unroll
                    for (int e = 0; e < 4; ++e) v[e] = ph == 0 ? v[e] * cs[e] - pr[e] * sn[e] : v[e] * cs[e] + pr[e] * sn[e];
                }
#pragma unroll
                for (int e = 0; e < 4; ++e) v[e] *= qscale;
                *(u32x2*)(Q + (size_t)row * 1536 + c16 + fq * 4) = pack4(v);
            }
        }
    }
};

template <class Epi>
__device__ __forceinline__ void gemm_tiles(const bf16_t* A, int lda, const bf16_t* Bt, int ldb, int M, int N, int K, const Epi& epi, unsigned char* smem, int rot) {
    constexpr int AS = 72;
    bf16_t* As = (bf16_t*)smem;
    bf16_t* Bs = As + 2 * 256 * AS;
    const int tid = tid_opaque(), wid = __builtin_amdgcn_readfirstlane(tid >> 6), lane = tid & 63, fr = lane & 15, fq = lane >> 4;
    const int wm = wid >> 1, wn = wid & 1;
    const int nM = M >> 8, nN = N >> 7, nT = nM * nN, nk = K >> 6;
    const int G = gridDim.x;
    const int b = (bid_opaque() + G - (rot % G)) % G;
    const int lr = tid >> 3, lc = (tid & 7) * 8;
    for (int t = b; t < nT; t += G) {
        const int tn = t / nM, tm = t % nM;
        const bf16_t* Ag = A + (size_t)(tm * 256 + lr) * lda + lc;
        const bf16_t* Bg = Bt + (size_t)(tn * 128 + lr) * ldb + lc;
        __syncthreads();
        f32x4 acc[4][4];
#pragma unroll
        for (int i = 0; i < 4; ++i)
#pragma unroll
            for (int j = 0; j < 4; ++j) acc[i][j] = (f32x4){0.f, 0.f, 0.f, 0.f};
        u32x4 ra0[4], rb0[2], ra1[4], rb1[2];
#define G_LOAD(RA, RB, kt_) { _Pragma("unroll") for (int i = 0; i < 4; ++i) RA[i] = *(const u32x4*)(Ag + (size_t)(64 * i) * lda + (kt_) * 64); \
                              _Pragma("unroll") for (int i = 0; i < 2; ++i) RB[i] = *(const u32x4*)(Bg + (size_t)(64 * i) * ldb + (kt_) * 64); }
#define G_STORE(RA, RB, buf_) { _Pragma("unroll") for (int i = 0; i < 4; ++i) *(u32x4*)(As + ((buf_) * 256 + lr + 64 * i) * AS + lc) = RA[i]; \
                                _Pragma("unroll") for (int i = 0; i < 2; ++i) *(u32x4*)(Bs + ((buf_) * 128 + lr + 64 * i) * AS + lc) = RB[i]; }
#define G_COMPUTE(cur_) { const bf16_t* Ac = As + ((cur_) * 256 + wm * 64 + fr) * AS + fq * 8; const bf16_t* Bc = Bs + ((cur_) * 128 + wn * 64 + fr) * AS + fq * 8; \
            _Pragma("unroll") for (int ks = 0; ks < 2; ++ks) { bf16x8 af[4], bfr[4]; \
                _Pragma("unroll") for (int mt = 0; mt < 4; ++mt) af[mt] = *(const bf16x8*)(Ac + mt * 16 * AS + ks * 32); \
                _Pragma("unroll") for (int nt = 0; nt < 4; ++nt) bfr[nt] = *(const bf16x8*)(Bc + nt * 16 * AS + ks * 32); \
                _Pragma("unroll") for (int mt = 0; mt < 4; ++mt) _Pragma("unroll") for (int nt = 0; nt < 4; ++nt) acc[mt][nt] = mfma16(bfr[nt], af[mt], acc[mt][nt]); } }
        G_LOAD(ra0, rb0, 0);
        G_LOAD(ra1, rb1, 1);
        G_STORE(ra0, rb0, 0);
        __syncthreads();
        for (int kt = 0; kt < nk; kt += 2) {
            { const int k2 = kt + 2 < nk ? kt + 2 : kt; G_LOAD(ra0, rb0, k2); }
            G_COMPUTE(0);
            G_STORE(ra1, rb1, 1);
            __syncthreads();
            { const int k3 = kt + 3 < nk ? kt + 3 : kt + 1; G_LOAD(ra1, rb1, k3); }
            G_COMPUTE(1);
            if (kt + 2 < nk) G_STORE(ra0, rb0, 0);
            __syncthreads();
        }
#undef G_LOAD
#undef G_STORE
#undef G_COMPUTE
        epi(acc, tm * 256 + wm * 64, tn * 128 + wn * 64, fr, fq);
    }
}


namespace pg8 {
#define PG8_LAS __attribute__((address_space(3)))
constexpr int BM = 256, BK = 64, HALF = 128, HTB = HALF * BK * 2, NXCD = 8, WGM = 8;
__device__ __forceinline__ int lds_byte(int r, int c) { const int st = (r >> 4) * 2 + (c >> 5), rr = r & 15, cc = c & 31, ob = rr * 64 + cc * 2; return st * 1024 + (ob ^ (((ob >> 9) & 1) << 5)); }
__device__ __forceinline__ void stage_rc(int b, int& R, int& C) { const int st = b / 1024, sb = b % 1024, swz = sb ^ (((sb >> 9) & 1) << 5); R = (st >> 1) * 16 + swz / 64; C = (st & 1) * 32 + (swz % 64) / 2; }
__device__ __forceinline__ int perm32(int rho) { const int n = rho >> 4, i = rho & 15; return 8 * (i >> 2) + 4 * n + (i & 3); }
struct Unit { int pm, pn; };
struct StaticOrder {
    int nM, nN, nwg, G, c;
    __device__ void init(int M, int N, int G_, int c_) { nM = M / BM; nN = N / BM; nwg = nM * nN; G = G_; c = c_; }
    __device__ bool next(int i, Unit& u) const {
        const long L = (long)i * G + c; if (L >= nwg) return false;
        int wgid = (int)L; { const int q = nwg / NXCD, r = nwg % NXCD, xcd = wgid % NXCD, off = wgid / NXCD; wgid = (xcd < r ? xcd * (q + 1) : r * (q + 1) + (xcd - r) * q) + off; }
        const int nig = WGM * nN, gid = wgid / nig, fm = gid * WGM, gsz = (nM - fm) < WGM ? (nM - fm) : WGM;
        u.pm = fm + ((wgid % nig) % gsz); u.pn = (wgid % nig) / gsz; return true;
    }
};
template <class Epi, class Sched>
__device__ __forceinline__ void gemm_phase(PG8_LAS unsigned char* lds, const bf16_t* A, const bf16_t* Bt, int K, const Sched& S, const Epi& E, int ld = 0, int nNreal = 1 << 20) {
    if (ld == 0) ld = K;
    const int tid = tid_opaque(), wid = __builtin_amdgcn_readfirstlane(tid >> 6), lane = tid & 63, wr = wid >> 2, wc = wid & 3, fr = lane & 15, fq = lane >> 4;
    const int nt = K / BK;
    unsigned voffA[2], voffB[2];
#pragma unroll
    for (int i = 0; i < 2; ++i) { int R, C; stage_rc(tid * 16 + i * 8192, R, C); const int Rb = Epi::PERM ? ((R & ~31) + perm32(R & 31)) : R;
        voffA[i] = (unsigned)(R * ld + C) * 2u; voffB[i] = (unsigned)(Rb * ld + C) * 2u; }
    const size_t kstep = (size_t)(BK * 2);
    const size_t hstep = (size_t)HALF * ld * 2;
    const size_t tstep = 2 * hstep;
    const unsigned ldsw = (unsigned)wid * 1024u;
    const int aoff = lds_byte(wr * 64 + fr, fq * 8), boff = lds_byte(wc * 32 + fr, fq * 8);
#define PG8_SA(b, h) (((b) * 2 + (h)) * HTB)
#define PG8_SB(b, h) ((4 + (b) * 2 + (h)) * HTB)
#define PG8_STAGE(bufoff, gbase, voff) do { _Pragma("unroll") for (int _i = 0; _i < 2; ++_i) \
        __builtin_amdgcn_global_load_lds((const unsigned*)((const char*)(gbase) + (voff)[_i]), (PG8_LAS unsigned*)(lds + (bufoff) + ldsw + _i * 8192), 16, 0, 0); } while (0)
#define PG8_LDA(dst, b, h) do { _Pragma("unroll") for (int m = 0; m < 4; ++m) _Pragma("unroll") for (int k = 0; k < 2; ++k) dst[m][k] = *(const PG8_LAS bf16x8*)(lds + PG8_SA(b, h) + aoff + m * 2048 + k * 1024); } while (0)
#define PG8_LDB(dst, b, h) do { _Pragma("unroll") for (int n = 0; n < 2; ++n) _Pragma("unroll") for (int k = 0; k < 2; ++k) dst[n][k] = *(const PG8_LAS bf16x8*)(lds + PG8_SB(b, h) + boff + n * 2048 + k * 1024); } while (0)
#define PG8_MMA(ai, bj, At, Bt) do { __builtin_amdgcn_s_setprio(1); _Pragma("unroll") for (int m = 0; m < 4; ++m) _Pragma("unroll") for (int n = 0; n < 2; ++n) _Pragma("unroll") for (int k = 0; k < 2; ++k) \
        acc[ai][bj][m][n] = __builtin_amdgcn_mfma_f32_16x16x32_bf16(Bt[n][k], At[m][k], acc[ai][bj][m][n], 0, 0, 0); __builtin_amdgcn_s_setprio(0); } while (0)
#define PG8_WAIT_V(n) asm volatile("s_waitcnt vmcnt(" #n ")" ::: "memory")
#define PG8_WAIT_L(n) asm volatile("s_waitcnt lgkmcnt(" #n ")" ::: "memory")
#define PG8_BAR __builtin_amdgcn_s_barrier()
#define PG8_SCHED __builtin_amdgcn_sched_barrier(0)
    Unit cur, nxt; int ui = 0;
    if (!S.next(0, cur)) return;
    f32x4 acc[2][2][4][2];
#pragma unroll
    for (int a = 0; a < 2; ++a)
#pragma unroll
        for (int b = 0; b < 2; ++b)
#pragma unroll
            for (int m = 0; m < 4; ++m)
#pragma unroll
                for (int n = 0; n < 2; ++n) acc[a][b][m][n] = (f32x4){0.f, 0.f, 0.f, 0.f};
    bf16x8 At[4][2], B0[2][2], B1[2][2];
    const size_t ksb = (size_t)K * 2;
    const char* cA = (const char*)A + (size_t)cur.pm * tstep + (size_t)(cur.pn / nNreal) * ksb; const char* cB = (const char*)Bt + (size_t)(cur.pn % nNreal) * tstep + (size_t)(cur.pn / nNreal) * ksb;
    PG8_STAGE(PG8_SB(0, 0), cB, voffB); PG8_STAGE(PG8_SA(0, 0), cA, voffA); PG8_STAGE(PG8_SB(0, 1), cB + hstep, voffB); PG8_STAGE(PG8_SA(0, 1), cA + hstep, voffA);
    if (wr == 1) PG8_BAR;
    PG8_WAIT_V(4); PG8_BAR;
    PG8_STAGE(PG8_SB(1, 0), cB + kstep, voffB); PG8_STAGE(PG8_SA(1, 0), cA + kstep, voffA); PG8_STAGE(PG8_SB(1, 1), cB + hstep + kstep, voffB);
    PG8_WAIT_V(6); PG8_BAR;
    for (;;) {
        const bool has_next = S.next(ui + 1, nxt);
        const char* nA = has_next ? (const char*)A + (size_t)nxt.pm * tstep + (size_t)(nxt.pn / nNreal) * ksb : cA; const char* nB = has_next ? (const char*)Bt + (size_t)(nxt.pn % nNreal) * tstep + (size_t)(nxt.pn / nNreal) * ksb : cB;
        for (int t = 0; t < nt; t += 2) {
            const bool last = (t == nt - 2);
            const char* a1 = cA + (size_t)(t + 1) * kstep;
            const char* a2 = last ? nA : cA + (size_t)(t + 2) * kstep; const char* b2 = last ? nB : cB + (size_t)(t + 2) * kstep;
            const char* a3 = a2 + kstep; const char* b3 = b2 + kstep;
            PG8_LDB(B0, 0, 0); PG8_SCHED; PG8_LDA(At, 0, 0); PG8_STAGE(PG8_SA(1, 1), a1 + hstep, voffA);
            PG8_WAIT_L(8); PG8_BAR; PG8_WAIT_L(0); PG8_MMA(0, 0, At, B0); PG8_BAR; PG8_SCHED;
            PG8_LDB(B1, 0, 1); PG8_STAGE(PG8_SB(0, 0), b2, voffB);
            PG8_BAR; PG8_WAIT_L(0); PG8_MMA(0, 1, At, B1); PG8_BAR;
            PG8_LDA(At, 0, 1); PG8_STAGE(PG8_SA(0, 0), a2, voffA);
            PG8_BAR; PG8_WAIT_L(0); PG8_MMA(1, 0, At, B0); PG8_BAR; PG8_SCHED;
            PG8_STAGE(PG8_SB(0, 1), b2 + hstep, voffB);
            PG8_WAIT_V(6); PG8_BAR; PG8_MMA(1, 1, At, B1); PG8_BAR;
            PG8_LDB(B0, 1, 0); PG8_SCHED; PG8_LDA(At, 1, 0); PG8_STAGE(PG8_SA(0, 1), a2 + hstep, voffA);
            PG8_WAIT_L(8); PG8_BAR; PG8_WAIT_L(0); PG8_MMA(0, 0, At, B0); PG8_BAR; PG8_SCHED;
            PG8_LDB(B1, 1, 1); PG8_STAGE(PG8_SB(1, 0), b3, voffB);
            PG8_BAR; PG8_WAIT_L(0); PG8_MMA(0, 1, At, B1); PG8_BAR;
            PG8_LDA(At, 1, 1); PG8_STAGE(PG8_SA(1, 0), a3, voffA);
            PG8_BAR; PG8_WAIT_L(0); PG8_MMA(1, 0, At, B0); PG8_BAR; PG8_SCHED;
            PG8_STAGE(PG8_SB(1, 1), b3 + hstep, voffB);
            PG8_WAIT_V(6); PG8_BAR; PG8_MMA(1, 1, At, B1); PG8_BAR;
        }
        E(acc, cur, wr, wc, fr, fq);
        if (!has_next) break;
#pragma unroll
        for (int a = 0; a < 2; ++a)
#pragma unroll
            for (int b = 0; b < 2; ++b)
#pragma unroll
                for (int m = 0; m < 4; ++m)
#pragma unroll
                    for (int n = 0; n < 2; ++n) acc[a][b][m][n] = (f32x4){0.f, 0.f, 0.f, 0.f};
        cur = nxt; cA = nA; cB = nB; ++ui;
    }
    PG8_WAIT_V(0);
    if (wr == 0) PG8_BAR;
    PG8_BAR;
#undef PG8_SA
#undef PG8_SB
#undef PG8_STAGE
#undef PG8_LDA
#undef PG8_LDB
#undef PG8_MMA
#undef PG8_WAIT_V
#undef PG8_WAIT_L
#undef PG8_BAR
#undef PG8_SCHED
}
}

struct Epi8SwiGLU {
    static constexpr bool PERM = false;
    bf16_t* U;
    __device__ __forceinline__ void operator()(const f32x4 (&acc)[2][2][4][2], const pg8::Unit& u, int wr, int wc, int fr, int fq) const {
#pragma unroll
        for (int ai = 0; ai < 2; ++ai)
#pragma unroll
            for (int m = 0; m < 4; ++m) {
                const int row = u.pm * 256 + ai * 128 + wr * 64 + m * 16 + fr;
#pragma unroll
                for (int n = 0; n < 2; ++n) {
                    f32x4 o;
#pragma unroll
                    for (int e = 0; e < 4; ++e) o[e] = silu_f(acc[ai][0][m][n][e]) * acc[ai][1][m][n][e];
                    *(u32x2*)(U + (size_t)row * DFF + u.pn * 128 + wc * 32 + n * 16 + fq * 4) = pack4(o);
                }
            }
    }
};
struct Epi8ResidSplit {
    static constexpr bool PERM = false;
    float* X; bf16_t* P; const float* gate; float s;
    __device__ __forceinline__ void operator()(const f32x4 (&acc)[2][2][4][2], const pg8::Unit& u, int wr, int wc, int fr, int fq) const {
        const int pn = u.pn & 3, ks = u.pn >> 2;
        const float* gr = gate + (size_t)modrow(u.pm * 256) * NMODC + pn * 256 + wc * 32 + fq * 4;
        f32x4 gv[2][2];
#pragma unroll
        for (int bj = 0; bj < 2; ++bj)
#pragma unroll
            for (int n = 0; n < 2; ++n) { gv[bj][n] = *(const f32x4*)(gr + bj * 128 + n * 16); gv[bj][n] *= s; }
#pragma unroll
        for (int ai = 0; ai < 2; ++ai)
#pragma unroll
            for (int m = 0; m < 4; ++m) {
                const int row = u.pm * 256 + ai * 128 + wr * 64 + m * 16 + fr;
                const size_t o0 = (size_t)row * D + pn * 256 + wc * 32 + fq * 4;
                if (ks == 0) {
                    f32x4 x[2][2];
#pragma unroll
                    for (int bj = 0; bj < 2; ++bj)
#pragma unroll
                        for (int n = 0; n < 2; ++n) x[bj][n] = *(const f32x4*)(X + o0 + bj * 128 + n * 16);
#pragma unroll
                    for (int bj = 0; bj < 2; ++bj)
#pragma unroll
                        for (int n = 0; n < 2; ++n) { x[bj][n] += gv[bj][n] * acc[ai][bj][m][n]; *(f32x4*)(X + o0 + bj * 128 + n * 16) = x[bj][n]; }
                } else {
#pragma unroll
                    for (int bj = 0; bj < 2; ++bj)
#pragma unroll
                        for (int n = 0; n < 2; ++n) { const f32x4 v = gv[bj][n] * acc[ai][bj][m][n]; *(u32x2*)(P + o0 + bj * 128 + n * 16) = pack4(v); }
                }
            }
    }
};
struct Epi8SSMIn {
    static constexpr bool PERM = false;
    bf16_t* ZXB; float* DTRAW;
    __device__ __forceinline__ void operator()(const f32x4 (&acc)[2][2][4][2], const pg8::Unit& u, int wr, int wc, int fr, int fq) const {
#pragma unroll
        for (int ai = 0; ai < 2; ++ai)
#pragma unroll
            for (int m = 0; m < 4; ++m) {
                const int row = u.pm * 256 + ai * 128 + wr * 64 + m * 16 + fr;
#pragma unroll
                for (int bj = 0; bj < 2; ++bj)
#pragma unroll
                    for (int n = 0; n < 2; ++n) {
                        const int col = u.pn * 256 + bj * 128 + wc * 32 + n * 16 + fq * 4;
                        if (col < 5120) *(u32x2*)(ZXB + (size_t)row * 5120 + col) = pack4(acc[ai][bj][m][n]);
                        else if (col < 5184) *(f32x4*)(DTRAW + (size_t)row * 64 + (col - 5120)) = acc[ai][bj][m][n];
                    }
            }
    }
};

__device__ __forceinline__ void phase_mlanorm(const float* __restrict__ QKVA, const float* __restrict__ qn, const float* __restrict__ kvn, const float* __restrict__ cache, int j,
                              const float* __restrict__ rope, bf16_t* __restrict__ QA, bf16_t* __restrict__ CKV, bf16_t* __restrict__ KR, float* __restrict__ out_cache) {
    const int tid_ = tid_opaque(); const int lane = tid_ & 63, gw = bid_opaque() * 8 + (tid_ >> 6), nW = gridDim.x * 8;
    for (int tok = gw; tok < NTOKKV; tok += nW) {
        if (tok < NTOK) {
            const float* r = QKVA + (size_t)tok * 800;
            const f32x4 q0 = *(const f32x4*)(r + lane * 4), q1 = *(const f32x4*)(r + 256 + lane * 4), kv = *(const f32x4*)(r + 512 + lane * 4);
            const float kr = lane < 32 ? r[768 + lane] : 0.f;
            float sq = 0.f, sk = 0.f;
#pragma unroll
            for (int e = 0; e < 4; ++e) { sq += q0[e] * q0[e] + q1[e] * q1[e]; sk += kv[e] * kv[e]; }
            const float rq = rsqrtf(wave_sum(sq) * (1.f / 512) + EPS), rk = rsqrtf(wave_sum(sk) * (1.f / 256) + EPS);
            const f32x4 g0 = *(const f32x4*)(qn + lane * 4), g1 = *(const f32x4*)(qn + 256 + lane * 4), gk = *(const f32x4*)(kvn + lane * 4);
            f32x4 a0, a1, ck;
#pragma unroll
            for (int e = 0; e < 4; ++e) { a0[e] = q0[e] * rq * g0[e]; a1[e] = q1[e] * rq * g1[e]; ck[e] = kv[e] * rk * gk[e]; }
            *(u32x2*)(QA + (size_t)tok * 512 + lane * 4) = pack4(a0);
            *(u32x2*)(QA + (size_t)tok * 512 + 256 + lane * 4) = pack4(a1);
            *(u32x2*)(CKV + (size_t)tok * 256 + lane * 4) = pack4(ck);
            float krv = kr;
            if (tok < 4096) {
                float* o = out_cache + ((size_t)((tok >> 8) * 2 + j) * 256 + (tok & 255)) * 288;
                *(f32x4*)(o + lane * 4) = ck;
                if (lane < 32) o[256 + lane] = kr;
            } else {
                const int pos = (tok - 4096) & 2047;
                const float partner = __shfl_xor(kr, 8);
                const int l31 = lane & 31, axis = l31 >> 4, ph = (l31 >> 3) & 1, f = l31 & 7;
                const float cs = rope[pos * 32 + axis * 8 + f], sn = rope[pos * 32 + 16 + axis * 8 + f];
                krv = ph == 0 ? kr * cs - partner * sn : kr * cs + partner * sn;
            }
            if (lane < 32) KR[(size_t)tok * 32 + lane] = f2bf(krv);
        } else {
            const int ct = tok - NTOK, bb = ct >> 8, pp = ct & 255;
            const float* c = cache + ((size_t)(bb * 2 + j) * 256 + pp) * 288;
            const f32x4 kv = *(const f32x4*)(c + lane * 4);
            *(u32x2*)(CKV + (size_t)tok * 256 + lane * 4) = pack4(kv);
            if (lane < 32) KR[(size_t)tok * 32 + lane] = f2bf(c[256 + lane]);
        }
    }
}

__device__ __forceinline__ void phase_attn(const bf16_t* __restrict__ Q, const bf16_t* __restrict__ KN, const bf16_t* __restrict__ KR, const bf16_t* __restrict__ VT, bf16_t* __restrict__ O, unsigned char* smem) {
    constexpr int KS = 104, VS = 72;
    bf16_t* Ks = (bf16_t*)smem;
    bf16_t* Vs = Ks + 2 * 64 * KS;
    const int tid = tid_opaque(), wid = __builtin_amdgcn_readfirstlane(tid >> 6), lane = tid & 63, fr = lane & 15, fq = lane >> 4;
    const int G = gridDim.x, b = bid_opaque();
    const int lrow = tid >> 3, lc8 = (tid & 7) * 8, rrow = (tid >> 2) & 63, rc8 = (tid & 3) * 8;
    for (int it = 0;; ++it) {
        const int idx = (it >> 1) * G + b;
        if (idx >= 256) break;
        const bool samp = (it & 1) == 0;
        int head, q0, nkt, sb = 0, kbase = 0;
        if (samp) { sb = idx >> 7; const int rem = idx & 127; head = rem >> 3; q0 = 4096 + sb * 2048 + (rem & 7) * 256; nkt = 36; }
        else { const int seq = idx >> 4; head = idx & 15; q0 = seq * 256; nkt = 4; kbase = seq * 256; }
        bf16x8 qf[2][3];
#pragma unroll
        for (int g = 0; g < 2; ++g)
#pragma unroll
            for (int ks = 0; ks < 3; ++ks) qf[g][ks] = *(const bf16x8*)(Q + (size_t)(q0 + wid * 32 + g * 16 + fr) * 1536 + head * 96 + ks * 32 + fq * 8);
        f32x4 ot[2][4];
#pragma unroll
        for (int g = 0; g < 2; ++g)
#pragma unroll
            for (int i = 0; i < 4; ++i) ot[g][i] = (f32x4){0.f, 0.f, 0.f, 0.f};
        float m[2] = {-1e30f, -1e30f}, l[2] = {0.f, 0.f};
        u32x4 rk, rr = {0u, 0u, 0u, 0u}, rv;
#define ATT_TB(kt) (samp ? ((kt) < 4 ? NTOK + sb * 256 + (kt) * 64 : 4096 + sb * 2048 + ((kt) - 4) * 64) : kbase + (kt) * 64)
#define ATT_GLOAD(kt) { const int tb = ATT_TB(kt); rk = *(const u32x4*)(KN + (size_t)(tb + lrow) * 1024 + head * 64 + lc8); \
            if (tid < 256) rr = *(const u32x4*)(KR + (size_t)(tb + rrow) * 32 + rc8); \
            rv = *(const u32x4*)(VT + (size_t)(head * 64 + lrow) * NTOKKV + tb + lc8); }
#define ATT_LSTORE(buf) { *(u32x4*)(Ks + ((buf) * 64 + lrow) * KS + lc8) = rk; if (tid < 256) *(u32x4*)(Ks + ((buf) * 64 + rrow) * KS + 64 + rc8) = rr; \
            *(u32x4*)(Vs + ((buf) * 64 + lrow) * VS + lc8) = rv; }
        ATT_GLOAD(0); ATT_LSTORE(0);
        __syncthreads();
#pragma unroll 1
        for (int kt = 0; kt < nkt; ++kt) {
            const int cur = kt & 1;
            if (kt + 1 < nkt) ATT_GLOAD(kt + 1);
            f32x4 st[2][4];
#pragma unroll
            for (int jt = 0; jt < 4; ++jt) {
                st[0][jt] = (f32x4){0.f, 0.f, 0.f, 0.f}; st[1][jt] = (f32x4){0.f, 0.f, 0.f, 0.f};
#pragma unroll
                for (int ks = 0; ks < 3; ++ks) {
                    const bf16x8 a = *(const bf16x8*)(Ks + (cur * 64 + jt * 16 + fr) * KS + ks * 32 + fq * 8);
                    st[0][jt] = mfma16(a, qf[0][ks], st[0][jt]);
                    st[1][jt] = mfma16(a, qf[1][ks], st[1][jt]);
                }
                asm volatile("" ::: "memory");
            }
            union { u32x4 u; bf16x8 v; } pb[2][2];
#pragma unroll
            for (int g = 0; g < 2; ++g) {
                float mloc = st[g][0][0];
#pragma unroll
                for (int jt = 0; jt < 4; ++jt)
#pragma unroll
                    for (int e = 0; e < 4; ++e) mloc = fmaxf(mloc, st[g][jt][e]);
                mloc = fmaxf(mloc, __shfl_xor(mloc, 16)); mloc = fmaxf(mloc, __shfl_xor(mloc, 32));
                const float mn = fmaxf(m[g], mloc), alpha = __builtin_amdgcn_exp2f(m[g] - mn);
                m[g] = mn;
                float psum = 0.f;
#pragma unroll
                for (int jt = 0; jt < 4; ++jt)
#pragma unroll
                    for (int e = 0; e < 4; ++e) { st[g][jt][e] = __builtin_amdgcn_exp2f(st[g][jt][e] - mn); psum += st[g][jt][e]; }
                l[g] = l[g] * alpha + psum;
#pragma unroll
                for (int i = 0; i < 4; ++i) ot[g][i] *= alpha;
#pragma unroll
                for (int s = 0; s < 2; ++s) {
                    pb[g][s].u.x = pk2(st[g][2 * s][0], st[g][2 * s][1]); pb[g][s].u.y = pk2(st[g][2 * s][2], st[g][2 * s][3]);
                    pb[g][s].u.z = pk2(st[g][2 * s + 1][0], st[g][2 * s + 1][1]); pb[g][s].u.w = pk2(st[g][2 * s + 1][2], st[g][2 * s + 1][3]);
                }
            }
#pragma unroll
            for (int s = 0; s < 2; ++s)
#pragma unroll
                for (int dvt = 0; dvt < 4; ++dvt) {
                    const bf16_t* vp = Vs + (cur * 64 + dvt * 16 + fr) * VS + s * 32 + fq * 4;
                    union { u32x4 u; bf16x8 v; } va;
                    const u32x2 lo = *(const u32x2*)vp, hi = *(const u32x2*)(vp + 16);
                    va.u.x = lo.x; va.u.y = lo.y; va.u.z = hi.x; va.u.w = hi.y;
                    ot[0][dvt] = mfma16(va.v, pb[0][s].v, ot[0][dvt]);
                    ot[1][dvt] = mfma16(va.v, pb[1][s].v, ot[1][dvt]);
                    asm volatile("" ::: "memory");
                }
            if (kt + 1 < nkt) ATT_LSTORE(cur ^ 1);
            __syncthreads();
        }
#pragma unroll
        for (int g = 0; g < 2; ++g) {
            float lt = l[g];
            lt += __shfl_xor(lt, 16); lt += __shfl_xor(lt, 32);
            const float inv = 1.f / lt;
#pragma unroll
            for (int dvt = 0; dvt < 4; ++dvt) {
                f32x4 o = ot[g][dvt] * inv;
                *(u32x2*)(O + (size_t)(q0 + wid * 32 + g * 16 + fr) * 1024 + head * 64 + dvt * 16 + fq * 4) = pack4(o);
            }
        }
    }
#undef ATT_TB
#undef ATT_GLOAD
#undef ATT_LSTORE
}


__device__ __forceinline__ void phase_conv(const bf16_t* __restrict__ ZXB, const float* __restrict__ DTRAW, const float* __restrict__ cw, const float* __restrict__ cb, const float* __restrict__ dtb,
                           bf16_t* __restrict__ XS, bf16_t* __restrict__ XT, bf16_t* __restrict__ BM, bf16_t* __restrict__ BT, bf16_t* __restrict__ CM, float* __restrict__ DT, unsigned char* smem) {
    float* in = (float*)smem;
    bf16_t* ot = (bf16_t*)(smem + 34560);
    const int tid = tid_opaque(), G = gridDim.x;
    u32x4 pv[3];
#define CONV_LOAD(item_) { const int chunk_ = (item_) / 48, slab_ = (item_) % 48, t0_ = chunk_ * 128; int lo_, hi_; \
        if (chunk_ < 32) { lo_ = (chunk_ >> 1) * 256; hi_ = lo_ + 256; } else { lo_ = 4096 + ((chunk_ - 32) >> 4) * 2048; hi_ = lo_ + 2048; } \
        _Pragma("unroll") for (int k = 0; k < 3; ++k) { const int c = tid + k * NT, r = c >> 3, kc = c & 7, t = t0_ - 2 + r; pv[k] = (u32x4){0u, 0u, 0u, 0u}; \
            if (c < 132 * 8 && t >= lo_ && t < hi_) pv[k] = *(const u32x4*)(ZXB + (size_t)t * 5120 + 2048 + slab_ * 64 + kc * 8); } }
    const int item0 = bid_opaque();
    if (item0 < 64 * 48) CONV_LOAD(item0);
    for (int item = item0; item < 64 * 48; item += G) {
        const int chunk = item / 48, slab = item % 48, t0 = chunk * 128;
#pragma unroll
        for (int k = 0; k < 3; ++k) {
            const int c = tid + k * NT, r = c >> 3, kc = c & 7;
            if (c < 132 * 8) {
                const u32x4 v = pv[k];
                float* d = in + r * 65 + kc * 8;
                d[0] = bflo(v.x); d[1] = bfhi(v.x); d[2] = bflo(v.y); d[3] = bfhi(v.y); d[4] = bflo(v.z); d[5] = bfhi(v.z); d[6] = bflo(v.w); d[7] = bfhi(v.w);
            }
        }
        __syncthreads();
        if (item + G < 64 * 48) CONV_LOAD(item + G);
        {
            const int ch = tid & 63, tg = tid >> 6, cg_ = slab * 64 + ch;
            const float w0 = cw[cg_], w1 = cw[3072 + cg_], w2 = cw[2 * 3072 + cg_], w3 = cw[3 * 3072 + cg_], w4 = cw[4 * 3072 + cg_], bias = cb[cg_];
            const float* ip = in + (tg * 16) * 65 + ch;
            float x0 = ip[0], x1 = ip[65], x2 = ip[130], x3 = ip[195];
#pragma unroll
            for (int tt = 0; tt < 16; ++tt) {
                const float x4 = ip[(tt + 4) * 65];
                const float a = bias + x0 * w0 + x1 * w1 + x2 * w2 + x3 * w3 + x4 * w4;
                ot[(tg * 16 + tt) * 66 + ch] = f2bf(silu_f(a));
                x0 = x1; x1 = x2; x2 = x3; x3 = x4;
            }
        }
        __syncthreads();
        bf16_t* dst; int ld, col; bf16_t* tdst = nullptr;
        if (slab < 32) { dst = XS; ld = 2048; col = slab * 64; tdst = XT + ((size_t)chunk * 2048 + slab * 64) * 128; }
        else if (slab < 40) { dst = BM; ld = 512; col = (slab - 32) * 64; tdst = BT + ((size_t)chunk * 512 + (slab - 32) * 64) * 128; }
        else { dst = CM; ld = 512; col = (slab - 40) * 64; }
#pragma unroll
        for (int i = 0; i < 2; ++i) {
            const int c = tid + i * NT, r = c >> 3, kc = c & 7;
            const unsigned* s32 = (const unsigned*)ot + r * 33 + kc * 4;
            u32x4 o; o.x = s32[0]; o.y = s32[1]; o.z = s32[2]; o.w = s32[3];
            *(u32x4*)(dst + (size_t)(t0 + r) * ld + col + kc * 8) = o;
        }
        if (tdst) {
#pragma unroll
            for (int i = 0; i < 2; ++i) {
                const int c = tid + i * NT, chh = c >> 4, jc = c & 15;
                const bf16_t* s = ot + (jc * 8) * 66 + chh;
                u32x4 o;
                o.x = (unsigned)s[0] | ((unsigned)s[66] << 16); o.y = (unsigned)s[2 * 66] | ((unsigned)s[3 * 66] << 16);
                o.z = (unsigned)s[4 * 66] | ((unsigned)s[5 * 66] << 16); o.w = (unsigned)s[6 * 66] | ((unsigned)s[7 * 66] << 16);
                *(u32x4*)(tdst + (size_t)chh * 128 + jc * 8) = o;
            }
        }
    }
#undef CONV_LOAD
    __syncthreads();
    for (int i = bid_opaque() * NT + tid; i < NTOK * 64; i += G * NT) {
        const float v = DTRAW[i] + dtb[i & 63];
        DT[i] = v > 20.f ? v : log1pf(__expf(v));
    }
}

__device__ __forceinline__ void phase_ssd(const bf16_t* __restrict__ XT, const bf16_t* __restrict__ BM, const bf16_t* __restrict__ BT, const bf16_t* __restrict__ CM, const float* __restrict__ DT,
                          const float* __restrict__ a_log, const float* __restrict__ state_in, int j, bf16_t* __restrict__ YF, bf16_t* __restrict__ YB, float* __restrict__ out_state, unsigned char* smem) {
    constexpr int LS = 136;
    bf16_t* Cs = (bf16_t*)smem;
    bf16_t* Bs = Cs + 128 * LS;
    bf16_t* BTs = Bs + 128 * LS;
    bf16_t* XTs = BTs + 128 * LS;
    bf16_t* Hs = XTs + 64 * LS;
    float* cum = (float*)(Hs + 64 * LS);
    float* dts = cum + 128;
    float* wj = dts + 128;
    float* misc = wj + 128;
    const int tid = tid_opaque(), wid = __builtin_amdgcn_readfirstlane(tid >> 6), lane = tid & 63, fr = lane & 15, fq = lane >> 4;
    const int G = gridDim.x;
    const int strip = wid < 4 ? wid : 11 - wid;
    const int pt = wid & 3, nt0 = (wid >> 2) * 4;
    const int lr = tid >> 4, lc = (tid & 15) * 8;
    const int irow = strip * 16 + fr;
    for (int w = bid_opaque(); w < 256; w += G) {
        const bool samp = w < 128;
#define SSD_DECODE(step_, seq_, dir_, head_, t0_, first_, last_) { \
            if (samp) { seq_ = w >> 6; dir_ = (w >> 5) & 1; head_ = w & 31; const int c_ = dir_ ? 15 - (step_) : (step_); t0_ = 4096 + seq_ * 2048 + c_ * 128; first_ = (step_) == 0; last_ = (step_) == 15; } \
            else { const int pu_ = (w - 128) * 8 + ((step_) >> 1); seq_ = pu_ >> 6; dir_ = (pu_ >> 5) & 1; head_ = pu_ & 31; const int cc_ = (step_) & 1, c_ = dir_ ? 1 - cc_ : cc_; t0_ = seq_ * 256 + c_ * 128; first_ = cc_ == 0; last_ = cc_ == 1; } }
        u32x4 rC[4], rB[4], rBT[4], rX[2]; float rd0 = 0.f, rd1 = 0.f;
#define SSD_ISSUE(step_) { int seq_n, dir_n, head_n, t0_n; bool f_n, l_n; SSD_DECODE(step_, seq_n, dir_n, head_n, t0_n, f_n, l_n); (void)f_n; (void)l_n; (void)seq_n; \
            const int grp_n = head_n >> 3, chunk_n = t0_n >> 7; \
            if (wid == 0) { rd0 = DT[(size_t)(t0_n + lane) * 64 + dir_n * 32 + head_n]; rd1 = DT[(size_t)(t0_n + 64 + lane) * 64 + dir_n * 32 + head_n]; } \
            _Pragma("unroll") for (int i = 0; i < 4; ++i) { const int r = lr + 32 * i; \
                rC[i] = *(const u32x4*)(CM + (size_t)(t0_n + r) * 512 + grp_n * 128 + lc); \
                rB[i] = *(const u32x4*)(BM + (size_t)(t0_n + r) * 512 + grp_n * 128 + lc); \
                rBT[i] = *(const u32x4*)(BT + ((size_t)chunk_n * 512 + grp_n * 128 + r) * 128 + lc); } \
            _Pragma("unroll") for (int i = 0; i < 2; ++i) { const int r = lr + 32 * i; rX[i] = *(const u32x4*)(XT + ((size_t)chunk_n * 2048 + head_n * 64 + r) * 128 + lc); } }
        SSD_ISSUE(0);
        f32x4 hacc[4];
#pragma unroll
        for (int k = 0; k < 4; ++k) hacc[k] = (f32x4){0.f, 0.f, 0.f, 0.f};
        for (int step = 0; step < 16; ++step) {
            int seq, dir, head, t0; bool first, last;
            SSD_DECODE(step, seq, dir, head, t0, first, last);
            const float A2 = -__expf(a_log[dir * 32 + head]) * 1.44269504f;
            bf16_t* Y = dir ? YB : YF;
            const size_t sbase = ((((size_t)(seq * 2 + j) * 2 + dir) * 32 + head) * 64 + pt * 16 + fr) * 128 + fq * 4;
            if (first) {
#pragma unroll
                for (int k = 0; k < 4; ++k) hacc[k] = samp ? *(const f32x4*)(state_in + sbase + (nt0 + k) * 16) : (f32x4){0.f, 0.f, 0.f, 0.f};
            }
#pragma unroll
            for (int k = 0; k < 4; ++k) *(u32x2*)(Hs + (pt * 16 + fr) * LS + (nt0 + k) * 16 + fq * 4) = pack4(hacc[k]);
#pragma unroll
            for (int i = 0; i < 4; ++i) {
                const int r = lr + 32 * i;
                *(u32x4*)(Cs + r * LS + lc) = rC[i]; *(u32x4*)(Bs + r * LS + lc) = rB[i]; *(u32x4*)(BTs + r * LS + lc) = rBT[i];
            }
#pragma unroll
            for (int i = 0; i < 2; ++i) *(u32x4*)(XTs + (lr + 32 * i) * LS + lc) = rX[i];
            if (wid == 0) {
                const float d0 = rd0, d1 = rd1;
                const float v0 = d0 * A2, v1 = d1 * A2;
                float p0 = v0, p1 = v1;
#pragma unroll
                for (int o = 1; o < 64; o <<= 1) { const float a = __shfl_up(p0, o), bq = __shfl_up(p1, o); if (lane >= o) { p0 += a; p1 += bq; } }
                p1 += __shfl(p0, 63);
                const float total = __shfl(p1, 63);
                const float c0 = dir ? total - p0 + v0 : p0, c1 = dir ? total - p1 + v1 : p1;
                cum[lane] = c0; cum[64 + lane] = c1; dts[lane] = d0; dts[64 + lane] = d1;
                wj[lane] = d0 * __builtin_amdgcn_exp2f(total - c0); wj[64 + lane] = d1 * __builtin_amdgcn_exp2f(total - c1);
                if (lane == 0) misc[0] = total;
            }
            __syncthreads();
            if (step + 1 < 16) SSD_ISSUE(step + 1);
            const float ci = cum[irow];
            bf16x8 cf[4];
#pragma unroll
            for (int ns = 0; ns < 4; ++ns) cf[ns] = *(const bf16x8*)(Cs + irow * LS + ns * 32 + fq * 8);
            f32x4 yo[4];
#pragma unroll
            for (int i = 0; i < 4; ++i) yo[i] = (f32x4){0.f, 0.f, 0.f, 0.f};
#pragma unroll
            for (int ns = 0; ns < 4; ++ns)
#pragma unroll
                for (int pp = 0; pp < 4; ++pp) {
                    const bf16x8 a = *(const bf16x8*)(Hs + (pp * 16 + fr) * LS + ns * 32 + fq * 8);
                    yo[pp] = mfma16(a, cf[ns], yo[pp]);
                }
            {
                const float e = __builtin_amdgcn_exp2f(ci);
#pragma unroll
                for (int i = 0; i < 4; ++i) yo[i] *= e;
            }
#pragma unroll
            for (int js = 0; js < 4; ++js) {
                const bool need0 = dir ? (2 * js >= strip) : (2 * js <= strip), need1 = dir ? (2 * js + 1 >= strip) : (2 * js + 1 <= strip);
                if (need0 || need1) {
                    f32x4 g2[2];
#pragma unroll
                    for (int h = 0; h < 2; ++h) {
                        const int jt = js * 2 + h;
                        f32x4 g = {0.f, 0.f, 0.f, 0.f};
                        if (h == 0 ? need0 : need1) {
#pragma unroll
                            for (int ns = 0; ns < 4; ++ns) {
                                const bf16x8 a = *(const bf16x8*)(Bs + (jt * 16 + fr) * LS + ns * 32 + fq * 8);
                                g = mfma16(a, cf[ns], g);
                            }
                            const f32x4 cj = *(const f32x4*)(cum + jt * 16 + fq * 4), dj = *(const f32x4*)(dts + jt * 16 + fq * 4);
                            if (jt == strip) {
#pragma unroll
                                for (int e = 0; e < 4; ++e) {
                                    const int jj = jt * 16 + fq * 4 + e;
                                    const bool ok = dir ? (jj >= irow) : (jj <= irow);
                                    g[e] = ok ? g[e] * __builtin_amdgcn_exp2f(fminf(ci - cj[e], 0.f)) * dj[e] : 0.f;
                                }
                            } else {
#pragma unroll
                                for (int e = 0; e < 4; ++e) g[e] = g[e] * __builtin_amdgcn_exp2f(fminf(ci - cj[e], 0.f)) * dj[e];
                            }
                        }
                        g2[h] = g;
                    }
                    union { u32x4 u; bf16x8 v; } mb;
                    mb.u.x = pk2(g2[0][0], g2[0][1]); mb.u.y = pk2(g2[0][2], g2[0][3]);
                    mb.u.z = pk2(g2[1][0], g2[1][1]); mb.u.w = pk2(g2[1][2], g2[1][3]);
#pragma unroll
                    for (int pp = 0; pp < 4; ++pp) {
                        const bf16_t* xp = XTs + (pp * 16 + fr) * LS + js * 32 + fq * 4;
                        union { u32x4 u; bf16x8 v; } va;
                        const u32x2 lo = *(const u32x2*)xp, hi = *(const u32x2*)(xp + 16);
                        va.u.x = lo.x; va.u.y = lo.y; va.u.z = hi.x; va.u.w = hi.y;
                        yo[pp] = mfma16(va.v, mb.v, yo[pp]);
                    }
                }
            }
#pragma unroll
            for (int pp = 0; pp < 4; ++pp) *(u32x2*)(Y + (size_t)(t0 + irow) * 2048 + head * 64 + pp * 16 + fq * 4) = pack4(yo[pp]);
            {
                const float dec = __builtin_amdgcn_exp2f(misc[0]);
#pragma unroll
                for (int k = 0; k < 4; ++k) hacc[k] *= dec;
#pragma unroll
                for (int js = 0; js < 4; ++js) {
                    const u32x4 xr = *(const u32x4*)(XTs + (pt * 16 + fr) * LS + js * 32 + fq * 8);
                    const f32x4 w0 = *(const f32x4*)(wj + js * 32 + fq * 8), w1 = *(const f32x4*)(wj + js * 32 + fq * 8 + 4);
                    union { u32x4 u; bf16x8 v; } xb;
                    xb.u.x = pk2(bflo(xr.x) * w0[0], bfhi(xr.x) * w0[1]); xb.u.y = pk2(bflo(xr.y) * w0[2], bfhi(xr.y) * w0[3]);
                    xb.u.z = pk2(bflo(xr.z) * w1[0], bfhi(xr.z) * w1[1]); xb.u.w = pk2(bflo(xr.w) * w1[2], bfhi(xr.w) * w1[3]);
#pragma unroll
                    for (int k = 0; k < 4; ++k) {
                        const bf16x8 a = *(const bf16x8*)(BTs + ((nt0 + k) * 16 + fr) * LS + js * 32 + fq * 8);
                        hacc[k] = mfma16(a, xb.v, hacc[k]);
                    }
                }
            }
            __syncthreads();
            if (last && !samp) {
#pragma unroll
                for (int k = 0; k < 4; ++k) *(f32x4*)(out_state + sbase + (nt0 + k) * 16) = hacc[k];
            }
        }
#undef SSD_DECODE
#undef SSD_ISSUE
    }
}

__device__ __forceinline__ void phase_gnorm(const bf16_t* __restrict__ YF, const bf16_t* __restrict__ YB, const bf16_t* __restrict__ XS, const bf16_t* __restrict__ ZXB, const float* __restrict__ dsk,
                            const float* __restrict__ ng, bf16_t* __restrict__ YN) {
    const int tid_ = tid_opaque(); const int lane = tid_ & 63, gw = bid_opaque() * 8 + (tid_ >> 6), nW = gridDim.x * 8;
#pragma unroll 2
    for (int tok = gw; tok < NTOK; tok += nW) {
        float v[4][8]; float ss = 0.f;
#pragma unroll
        for (int jj = 0; jj < 4; ++jj) {
            const int c = jj * 512 + lane * 8, head = c >> 6;
            const float ds = dsk[head] + dsk[32 + head];
            const u32x4 yf = *(const u32x4*)(YF + (size_t)tok * 2048 + c), yb = *(const u32x4*)(YB + (size_t)tok * 2048 + c);
            const u32x4 xs = *(const u32x4*)(XS + (size_t)tok * 2048 + c), z = *(const u32x4*)(ZXB + (size_t)tok * 5120 + c);
#pragma unroll
            for (int q = 0; q < 4; ++q) {
                const float y0 = bflo(yf[q]) + bflo(yb[q]) + ds * bflo(xs[q]), y1 = bfhi(yf[q]) + bfhi(yb[q]) + ds * bfhi(xs[q]);
                const float g0 = y0 * silu_f(bflo(z[q])), g1 = y1 * silu_f(bfhi(z[q]));
                v[jj][2 * q] = g0; v[jj][2 * q + 1] = g1; ss += g0 * g0 + g1 * g1;
            }
        }
        const float r = rsqrtf(wave_sum(ss) * (1.f / 2048) + EPS);
#pragma unroll
        for (int jj = 0; jj < 4; ++jj) {
            const int c = jj * 512 + lane * 8;
            const f32x4 g0 = *(const f32x4*)(ng + c), g1 = *(const f32x4*)(ng + c + 4);
            u32x4 o;
            o.x = pk2(v[jj][0] * r * g0[0], v[jj][1] * r * g0[1]); o.y = pk2(v[jj][2] * r * g0[2], v[jj][3] * r * g0[3]);
            o.z = pk2(v[jj][4] * r * g1[0], v[jj][5] * r * g1[1]); o.w = pk2(v[jj][6] * r * g1[2], v[jj][7] * r * g1[3]);
            *(u32x4*)(YN + (size_t)tok * 2048 + c) = o;
        }
    }
}

#ifndef PHASE_MASK
#define PHASE_MASK 0xFFFF
#endif
#define EN(x) (((PHASE_MASK) >> (x)) & 1)
constexpr int N_PHASES = 50;

__device__ __forceinline__ void run_phase(const Params& p, int ph, unsigned char* smem) {
    size_t zoff = 0; asm volatile("" : "+s"(zoff));
    unsigned char* ws = p.ws + zoff;
    float* X = (float*)(ws + WS_X);
    bf16_t* H = (bf16_t*)(ws + WS_H);
    bf16_t* U = (bf16_t*)(ws + WS_U);
    if (ph == 0) { if (EN(0)) phase0(p, smem); return; }
    if (ph == N_PHASES - 1) { if (EN(2)) phase_final(X, (const bf16_t*)(ws + WS_P), p.in[25], p.out + OUT_Y); return; }
    const int layer = (ph - 1) / 12, s = (ph - 1) % 12, j = layer >> 1;
    const bool is_mla = (layer & 1) == 0;
    const float* modl = (const float*)(ws + WS_MOD) + (size_t)layer * 3 * NMODC;
    if (s == 0 || s == 3 || s == 9) {
        const int ni = s == 0 ? 0 : (s == 3 ? 1 : 2);
        const bool hasP = ph != 1 && !(s == 9 && is_mla);
        if (EN(1)) phase_norm(X, hasP ? (const bf16_t*)(ws + WS_P) : (const bf16_t*)nullptr, p.in[8] + (size_t)(layer * 3 + ni) * D, modl, ni * 3, ni * 3 + 1, H);
        return;
    }
    if (s == 1 || s == 10) {
        const int f = s == 1 ? 0 : 1;
        Epi8SwiGLU e{U};
        pg8::StaticOrder so; so.init(NTOK, 5632, gridDim.x, bid_opaque());
        if (EN(3)) pg8::gemm_phase((PG8_LAS unsigned char*)smem, H, (const bf16_t*)(ws + WS_W1T) + (size_t)(layer * 2 + f) * 5632 * 1024, 1024, so, e);
        return;
    }
    if (s == 2 || s == 11 || s == 8) {
        const bf16_t* A; const bf16_t* Bt; int K; int chunk; float sc;
        if (s == 2 || s == 11) { const int f = s == 2 ? 0 : 1; A = U; K = DFF; Bt = (const bf16_t*)(ws + WS_W2T) + (size_t)(layer * 2 + f) * 1024 * 2816; chunk = s == 2 ? 2 : 8; sc = 0.5f; }
        else if (is_mla) { A = (const bf16_t*)(ws + WS_O); K = 1024; Bt = (const bf16_t*)(ws + WS_MWO) + (size_t)j * 1024 * 1024; chunk = 5; sc = 1.f; }
        else { A = (const bf16_t*)(ws + WS_YN); K = 2048; Bt = (const bf16_t*)(ws + WS_SWOUT) + (size_t)j * 1024 * 2048; chunk = 5; sc = 1.f; }
        if (s == 8 && is_mla) {
            EpiResid e{X, modl + chunk * 1024, sc};
            if (EN(4)) gemm_tiles(A, K, Bt, K, NTOK, 1024, K, e, smem, 0);
        } else {
            Epi8ResidSplit e{X, (bf16_t*)(ws + WS_P), modl + chunk * 1024, sc};
            pg8::StaticOrder so; so.init(NTOK, 2048, gridDim.x, bid_opaque());
            if (EN(4)) pg8::gemm_phase((PG8_LAS unsigned char*)smem, A, Bt, K / 2, so, e, K, 4);
        }
        return;
    }
    if (is_mla) {
        if (s == 4) {
            EpiF32 e{(float*)(ws + WS_QKVA), 800, 800};
            if (EN(5)) gemm_tiles(H, D, (const bf16_t*)(ws + WS_MWIN) + (size_t)j * MLA_NPAD * 1024, 1024, NTOK, MLA_NPAD, 1024, e, smem, 0);
        } else if (s == 5) {
            if (EN(6)) phase_mlanorm((const float*)(ws + WS_QKVA), p.in[12] + j * 512, p.in[13] + j * 256, p.in[2], j, (const float*)(ws + WS_ROPE),
                          (bf16_t*)(ws + WS_QA), (bf16_t*)(ws + WS_CKV), (bf16_t*)(ws + WS_KR), p.out + OUT_CACHE);
        } else if (s == 6) {
            EpiQ eq{(bf16_t*)(ws + WS_Q), (const float*)(ws + WS_ROPE), 0.14724444f  };
            if (EN(7)) gemm_tiles((const bf16_t*)(ws + WS_QA), 512, (const bf16_t*)(ws + WS_MWQB) + (size_t)j * 1536 * 512, 512, NTOK, 1536, 512, eq, smem, 0);
            {
                EpiBf16 e{(bf16_t*)(ws + WS_KN), 1024};
                if (EN(7)) gemm_tiles((const bf16_t*)(ws + WS_CKV), 256, (const bf16_t*)(ws + WS_MWKN) + (size_t)j * 1024 * 256, 256, NTOKKV, 1024, 256, e, smem, 128);
            }
            {
                EpiBf16T e{(bf16_t*)(ws + WS_VT), NTOKKV};
                if (EN(7)) gemm_tiles((const bf16_t*)(ws + WS_MWV) + (size_t)j * 1024 * 256, 256, (const bf16_t*)(ws + WS_CKV), 256, 1024, NTOKKV, 256, e, smem, 144);
            }
        } else if (s == 7) {
            if (EN(8)) phase_attn((const bf16_t*)(ws + WS_Q), (const bf16_t*)(ws + WS_KN), (const bf16_t*)(ws + WS_KR), (const bf16_t*)(ws + WS_VT), (bf16_t*)(ws + WS_O), smem);
        }
    } else {
        if (s == 4) {
            Epi8SSMIn e{(bf16_t*)(ws + WS_ZXB), (float*)(ws + WS_DTRAW)};
            pg8::StaticOrder so; so.init(NTOK, SSM_NPAD, gridDim.x, bid_opaque());
            if (EN(9)) pg8::gemm_phase((PG8_LAS unsigned char*)smem, H, (const bf16_t*)(ws + WS_SWIN) + (size_t)j * SSM_NPAD * 1024, 1024, so, e);
        } else if (s == 5) {
            if (EN(10)) phase_conv((const bf16_t*)(ws + WS_ZXB), (const float*)(ws + WS_DTRAW), p.in[18] + (size_t)j * 5 * 3072, p.in[19] + j * 3072, p.in[20] + j * 64,
                       (bf16_t*)(ws + WS_XS), (bf16_t*)(ws + WS_XT), (bf16_t*)(ws + WS_BM), (bf16_t*)(ws + WS_BT), (bf16_t*)(ws + WS_CM), (float*)(ws + WS_DT), smem);
        } else if (s == 6) {
            if (EN(11)) phase_ssd((const bf16_t*)(ws + WS_XT), (const bf16_t*)(ws + WS_BM), (const bf16_t*)(ws + WS_BT), (const bf16_t*)(ws + WS_CM), (const float*)(ws + WS_DT),
                      p.in[21] + j * 64, p.in[3], j, (bf16_t*)(ws + WS_YF), (bf16_t*)(ws + WS_YB), p.out + OUT_STATE, smem);
        } else if (s == 7) {
            if (EN(12)) phase_gnorm((const bf16_t*)(ws + WS_YF), (const bf16_t*)(ws + WS_YB), (const bf16_t*)(ws + WS_XS), (const bf16_t*)(ws + WS_ZXB), p.in[22] + j * 64, p.in[23] + j * 2048,
                        (bf16_t*)(ws + WS_YN));
        }
    }
}

#define XB_TMO      128
#define XB_XCNT(j)  (256  + 64 * (j))
#define XB_XSUB(j)  (1280 + 64 * (j))
#define XB_XGEN(j)  (2304 + 64 * (j))
#define XB_TOP      3328
#define XB_TOPGEN   3392
#define XCD_BAR_WORDS 3456
#define XB_SPIN_CAP (1u << 18)
#define LAS __attribute__((address_space(3)))

__device__ __forceinline__ unsigned xb_ld(unsigned* p)              { return __hip_atomic_load(p, __ATOMIC_RELAXED, __HIP_MEMORY_SCOPE_AGENT); }
__device__ __forceinline__ unsigned xb_add(unsigned* p, unsigned v) { return __hip_atomic_fetch_add(p, v, __ATOMIC_RELAXED, __HIP_MEMORY_SCOPE_AGENT); }
__device__ __forceinline__ unsigned xb_xcc_id() { return (unsigned)__builtin_amdgcn_s_getreg((3 << 11) | 20) & 0xFu; }
#define XB_SPIN(cond, bar) do { unsigned _sp = 0; while (cond) { __builtin_amdgcn_s_sleep(1); \
    if ((++_sp & 255u) == 0u) { if (xb_ld(&(bar)[XB_TMO])) break; if (_sp > XB_SPIN_CAP) { atomicAdd(&(bar)[XB_TMO], 1u); break; } } } } while (0)

struct XcdBarrier {
    unsigned* bar; unsigned x;
    volatile LAS unsigned* st;
};

__device__ __forceinline__ XcdBarrier xcd_barrier_post(unsigned* bar, volatile LAS unsigned* st) {
    XcdBarrier b; b.bar = bar; b.x = xb_xcc_id(); b.st = st;
    if (threadIdx.x == 0) (void)xb_add(&bar[XB_XCNT(b.x)], 1u);
    return b;
}
__device__ __forceinline__ void xcd_barrier_complete(unsigned* bar, unsigned x, unsigned& nloc, unsigned& nx) {
    const unsigned G = gridDim.x * gridDim.y * gridDim.z;
    unsigned sum, cnt, mine, sp = 0u;
    for (;;) {
        sum = 0u; cnt = 0u; mine = 0u;
#pragma unroll
        for (unsigned j = 0; j < 16; ++j) { const unsigned c = xb_ld(&bar[XB_XCNT(j)]); sum += c; cnt += (c > 0u) ? 1u : 0u; mine = (j == x) ? c : mine; }
        if (sum == G) break;
        __builtin_amdgcn_s_sleep(1);
        if ((++sp & 255u) == 0u) { if (xb_ld(&bar[XB_TMO])) break; if (sp > XB_SPIN_CAP) { atomicAdd(&bar[XB_TMO], 1u); break; } }
    }
    nloc = mine > 0u ? mine : 1u; nx = cnt > 0u ? cnt : 1u;
}

__device__ __forceinline__ void xcd_barrier(const XcdBarrier& b) {
    asm volatile("s_waitcnt vmcnt(0)" ::: "memory");
    __syncthreads();
    if (threadIdx.x == 0) {
        unsigned* bar = b.bar;
        __builtin_amdgcn_s_waitcnt(0);
        unsigned nloc = b.st[0], nx = b.st[1];
        if (nloc == 0u) { xcd_barrier_complete(bar, b.x, nloc, nx); b.st[0] = nloc; b.st[1] = nx; }
        const unsigned old = xb_add(&bar[XB_XSUB(b.x)], 1u);
        const unsigned gen = old / nloc;
        if (old + 1u == (gen + 1u) * nloc) {
            __builtin_amdgcn_fence(__ATOMIC_RELEASE, "agent");
            asm volatile("s_waitcnt vmcnt(0)" ::: "memory");
            const unsigned og = xb_add(&bar[XB_TOP], 1u);
            const unsigned tg = og / nx;
            if (og + 1u == (tg + 1u) * nx) xb_add(&bar[XB_TOPGEN], 1u);
            else XB_SPIN(xb_ld(&bar[XB_TOPGEN]) == tg, bar);
            __builtin_amdgcn_fence(__ATOMIC_ACQUIRE, "agent");
            xb_add(&bar[XB_XGEN(b.x)], 1u);
            asm volatile("s_waitcnt vmcnt(0)" ::: "memory");
        } else {
            XB_SPIN(xb_ld(&bar[XB_XGEN(b.x)]) == gen, bar);
            __builtin_amdgcn_fence(__ATOMIC_ACQUIRE, "agent");
            asm volatile("s_waitcnt vmcnt(0)" ::: "memory");
        }
    }
    __syncthreads();
}

__device__ __forceinline__ void grid_barrier(unsigned* ctr, unsigned target) {
    __syncthreads();
    if (threadIdx.x == 0) {
        __threadfence();
        __hip_atomic_fetch_add(ctr, 1u, __ATOMIC_RELAXED, __HIP_MEMORY_SCOPE_AGENT);
        while (__hip_atomic_load(ctr, __ATOMIC_RELAXED, __HIP_MEMORY_SCOPE_AGENT) < target) __builtin_amdgcn_s_sleep(1);
        __threadfence();
    }
    __syncthreads();
}

__global__ void __launch_bounds__(NT) mega_fwd(Params p) {
    extern __shared__ __attribute__((aligned(16))) unsigned char smem[];
    cg::grid_group grid = cg::this_grid();
    volatile LAS unsigned* xst = (volatile LAS unsigned*)(smem + LDS_BYTES - 16);
    if (threadIdx.x == 0) { xst[0] = 0u; xst[1] = 0u; }
    __syncthreads();
    XcdBarrier xb = xcd_barrier_post((unsigned*)(p.ws + WS_BAR), xst);
    for (int ph = p.ph_lo; ph < p.ph_hi; ++ph) {
        if (ph > p.ph_lo) { if (ph == 1) grid.sync(); else xcd_barrier(xb); }
        run_phase(p, ph, smem);
    }
}

extern "C" void kernel_launch(void* const* d_in, const int* in_sizes, int n_in, void* d_out, int out_size, void* d_ws, size_t ws_size, hipStream_t stream) {
    static int grid_blocks = 0;
    if (grid_blocks == 0) {
        if (n_in != 26 || ws_size < WS_END) { fprintf(stderr, "kernel_launch: unexpected n_in %d / ws_size %zu (need %zu)\n", n_in, ws_size, (size_t)WS_END); grid_blocks = -1; return; }
        int dev = 0, cus = 0, per_cu = 0;
        (void)hipGetDevice(&dev);
        (void)hipDeviceGetAttribute(&cus, hipDeviceAttributeMultiprocessorCount, dev);
        if (hipFuncSetAttribute((const void*)mega_fwd, hipFuncAttributeMaxDynamicSharedMemorySize, LDS_BYTES) != hipSuccess) { fprintf(stderr, "kernel_launch: hipFuncSetAttribute failed\n"); }
        if (hipOccupancyMaxActiveBlocksPerMultiprocessor(&per_cu, (const void*)mega_fwd, NT, LDS_BYTES) != hipSuccess || per_cu < 1) { fprintf(stderr, "kernel_launch: occupancy query says %d\n", per_cu); per_cu = 1; }
        (void)hipGetLastError();
        grid_blocks = cus * 1;
        if (grid_blocks <= 0) grid_blocks = 256;
    }
    if (grid_blocks < 0) return;
    Params p;
    memset(&p, 0, sizeof(p));
    for (int i = 0; i < 26; ++i) p.in[i] = (const float*)d_in[i];
    p.out = (float*)d_out; p.ws = (unsigned char*)d_ws;
#if N_LAUNCH_MODE == 1
    (void)hipMemsetAsync((unsigned char*)d_ws + WS_BAR, 0, 16384, stream);
    p.ph_lo = 0; p.ph_hi = N_PHASES;
    void* args[] = {&p};
    hipError_t e = hipLaunchCooperativeKernel((const void*)mega_fwd, dim3(grid_blocks), dim3(NT), args, LDS_BYTES, stream);
    if (e != hipSuccess) fprintf(stderr, "cooperative launch failed: %s (grid %d)\n", hipGetErrorString(e), grid_blocks);
#else
    for (int ph = 0; ph < N_PHASES; ++ph) {
#ifdef PH_LIMIT
        if (ph >= PH_LIMIT && ph != N_PHASES - 1) continue;
#endif
        p.ph_lo = ph; p.ph_hi = ph + 1;
        hipLaunchKernelGGL(mega_fwd, dim3(grid_blocks), dim3(NT), LDS_BYTES, stream, p);
    }
#endif
}
```
